# Optimizing an MI355X kernel written in HIP

```python
import jax, jax.numpy as jnp
from jax import lax
import numpy as np

D_MODEL = 1024
BATCH = 2
SEQ = 8192
DEPTH = 4

CHUNK = 128
A_HEADS = 4
A_WIDTH = D_MODEL // 2
A_HEAD_DIM = A_WIDTH // A_HEADS
B_WIDTH = D_MODEL // 2
B_GROUPS = 4
CONV_B_WIDTH = 31
CONV_B_PAD = CONV_B_WIDTH // 2
EVEN_IN = 2 * A_WIDTH + 2 * B_WIDTH
EVEN_MIX = A_WIDTH + B_WIDTH
C_WIDTH = D_MODEL
CONV_C_WIDTH = 3
CONV_C_PAD = CONV_C_WIDTH // 2
D_FF = 2816
N_EXPERTS = 8
TOP_K = 2
RMS_EPS = 1e-6
LN_EPS = 1e-5

kernel_name = "hybrid_gmlp_conformer_shortconv_moe_encoder"


def rmsnorm(x, g):
    xf = x.astype(jnp.float32)
    y = xf * lax.rsqrt(jnp.mean(xf * xf, axis=-1, keepdims=True) + RMS_EPS)
    return (y * g.astype(jnp.float32)).astype(x.dtype)


def layernorm(x, g, b):
    xf = x.astype(jnp.float32)
    mu = jnp.mean(xf, axis=-1, keepdims=True)
    xc = xf - mu
    y = xc * lax.rsqrt(jnp.mean(xc * xc, axis=-1, keepdims=True) + LN_EPS)
    return (y * g.astype(jnp.float32) + b.astype(jnp.float32)).astype(x.dtype)


def depthwise_conv(x, w, pad):
    c = x.shape[-1]
    return lax.conv_general_dilated(
        x, w[:, None, :].astype(x.dtype), window_strides=(1,), padding=[(pad, pad)],
        dimension_numbers=("NWC", "WIO", "NWC"), feature_group_count=c)


def swiglu(x, w1, w3, w2):
    return (jax.nn.silu(x @ w1) * (x @ w3)) @ w2


def mixer_ab(h, w_in, ws, bs, ln_a_g, ln_a_b, conv_w, conv_b, ln_b_g, ln_b_b, w_out):
    bsz, s, _ = h.shape
    z = h @ w_in
    a_z, b_a, b_g = z[..., :2 * A_WIDTH], z[..., 2 * A_WIDTH:2 * A_WIDTH + B_WIDTH], z[..., 2 * A_WIDTH + B_WIDTH:]
    a_z = jax.nn.gelu(a_z)
    a_u, a_v = a_z[..., :A_WIDTH], a_z[..., A_WIDTH:]
    a_v = layernorm(a_v, ln_a_g, ln_a_b)
    v = a_v.reshape(bsz, s // CHUNK, CHUNK, A_HEADS, A_HEAD_DIM)
    v = jnp.einsum("hts,bcshd->bcthd", ws, v) + bs.T[None, None, :, :, None]
    a_out = a_u * v.reshape(bsz, s, A_WIDTH)
    glu = b_a * jax.nn.sigmoid(b_g)
    c = depthwise_conv(glu, conv_w, CONV_B_PAD) + conv_b
    b_out = jax.nn.silu(layernorm(c, ln_b_g, ln_b_b))
    return jnp.concatenate([a_out, b_out], axis=-1) @ w_out


def mixer_c(h, w_in, conv_w, w_out):
    z = h @ w_in
    gate_b, gate_c, v = z[..., :C_WIDTH], z[..., C_WIDTH:2 * C_WIDTH], z[..., 2 * C_WIDTH:]
    y = gate_b * depthwise_conv(gate_c * v, conv_w, CONV_C_PAD)
    return y @ w_out


def moe_swiglu(h, router, w1, w3, w2):
    bsz, s, d = h.shape
    xf = h.reshape(bsz * s, d)
    logits = (xf @ router).astype(jnp.float32)
    top_v, top_i = lax.top_k(logits, TOP_K)
    gate = jax.nn.softmax(top_v, axis=-1)
    combine = jnp.einsum("nk,nke->ne", gate,
                         jax.nn.one_hot(top_i, N_EXPERTS, dtype=jnp.float32)).astype(h.dtype)
    out = jnp.zeros_like(xf)
    for e in range(N_EXPERTS):
        out = out + combine[:, e:e + 1] * swiglu(xf, w1[e], w3[e], w2[e])
    return out.reshape(bsz, s, d)


def setup_inputs(seed: int = 0) -> dict:
    key = jax.random.key(seed)
    ks = iter(jax.random.split(key, 32))
    n_even = (DEPTH + 1) // 2
    n_odd = DEPTH // 2
    f32 = jnp.float32

    def nrm(shape, scale):
        return jax.random.normal(next(ks), shape, f32) * scale

    def gain(shape):
        return 1.0 + 0.02 * jax.random.normal(next(ks), shape, f32)

    D = D_MODEL
    return {
        "x": jax.random.normal(next(ks), (BATCH, SEQ, D), f32),
        "norm_mix_g": gain((DEPTH, D)),
        "norm_ffn_g": gain((DEPTH, D)),
        "ev_w_in": nrm((n_even, D, EVEN_IN), D ** -0.5),
        "ev_ws": nrm((n_even, A_HEADS, CHUNK, CHUNK), CHUNK ** -0.5),
        "ev_bs": gain((n_even, A_HEADS, CHUNK)),
        "ev_ln_a_g": gain((n_even, A_WIDTH)),
        "ev_ln_a_b": nrm((n_even, A_WIDTH), 0.02),
        "ev_conv_w": nrm((n_even, CONV_B_WIDTH, B_WIDTH), CONV_B_WIDTH ** -0.5),
        "ev_conv_b": nrm((n_even, B_WIDTH), 0.02),
        "ev_ln_b_g": gain((n_even, B_WIDTH)),
        "ev_ln_b_b": nrm((n_even, B_WIDTH), 0.02),
        "ev_w_out": nrm((n_even, EVEN_MIX, D), EVEN_MIX ** -0.5),
        "od_w_in": nrm((n_odd, D, 3 * C_WIDTH), D ** -0.5),
        "od_conv_w": nrm((n_odd, CONV_C_WIDTH, C_WIDTH), CONV_C_WIDTH ** -0.5),
        "od_w_out": nrm((n_odd, C_WIDTH, D), C_WIDTH ** -0.5),
        "ffn_w1": nrm((n_even, D, D_FF), D ** -0.5),
        "ffn_w3": nrm((n_even, D, D_FF), D ** -0.5),
        "ffn_w2": nrm((n_even, D_FF, D), D_FF ** -0.5),
        "moe_router": nrm((n_odd, D, N_EXPERTS), D ** -0.5),
        "moe_w1": nrm((n_odd, N_EXPERTS, D, D_FF), D ** -0.5),
        "moe_w3": nrm((n_odd, N_EXPERTS, D, D_FF), D ** -0.5),
        "moe_w2": nrm((n_odd, N_EXPERTS, D_FF, D), D_FF ** -0.5),
        "final_g": gain((D,)),
    }


def reference(x, norm_mix_g, norm_ffn_g, ev_w_in, ev_ws, ev_bs, ev_ln_a_g, ev_ln_a_b,
              ev_conv_w, ev_conv_b, ev_ln_b_g, ev_ln_b_b, ev_w_out,
              od_w_in, od_conv_w, od_w_out, ffn_w1, ffn_w3, ffn_w2,
              moe_router, moe_w1, moe_w3, moe_w2, final_g):
    for layer in range(DEPTH):
        i = layer // 2
        hn = rmsnorm(x, norm_mix_g[layer])
        if layer % 2 == 0:
            x = x + mixer_ab(hn, ev_w_in[i], ev_ws[i], ev_bs[i], ev_ln_a_g[i], ev_ln_a_b[i],
                             ev_conv_w[i], ev_conv_b[i], ev_ln_b_g[i], ev_ln_b_b[i], ev_w_out[i])
            hn = rmsnorm(x, norm_ffn_g[layer])
            x = x + swiglu(hn, ffn_w1[i], ffn_w3[i], ffn_w2[i])
        else:
            x = x + mixer_c(hn, od_w_in[i], od_conv_w[i], od_w_out[i])
            hn = rmsnorm(x, norm_ffn_g[layer])
            x = x + moe_swiglu(hn, moe_router[i], moe_w1[i], moe_w3[i], moe_w2[i])
    return rmsnorm(x, final_g)
```

```cpp
#include <hip/hip_runtime.h>
#include <cstdio>

namespace pg8 {
#define PG8_LAS __attribute__((address_space(3)))
typedef unsigned short bf16_t;
typedef short bf16x8 __attribute__((ext_vector_type(8)));
typedef float f32x4 __attribute__((ext_vector_type(4)));
typedef float f32x2 __attribute__((ext_vector_type(2)));
typedef unsigned u32x4 __attribute__((ext_vector_type(4)));
typedef unsigned u32x2 __attribute__((ext_vector_type(2)));
typedef int v4i32 __attribute__((ext_vector_type(4)));
typedef int v8i32 __attribute__((ext_vector_type(8)));
constexpr int BM = 256, BK = 64, HALF = 128, HTB = HALF * BK * 2  , STAGE_BYTES = 8 * HTB, NXCD = 8;

__host__ __device__ __forceinline__ int lds_byte(int r, int c) { const int st = (r >> 4) * 2 + (c >> 5), rr = r & 15, cc = c & 31, ob = rr * 64 + cc * 2; return st * 1024 + (ob ^ (((ob >> 9) & 1) << 5)); }
__host__ __device__ __forceinline__ void stage_rc(int b, int& R, int& C) { const int st = b / 1024, sb = b % 1024, swz = sb ^ (((sb >> 9) & 1) << 5); R = (st >> 1) * 16 + swz / 64; C = (st & 1) * 32 + (swz % 64) / 2; }
__host__ __device__ __forceinline__ int perm32(int rho) { const int n = rho >> 4, i = rho & 15; return 8 * (i >> 2) + 4 * n + (i & 3); }

struct Unit { int pm, pn; };
struct Gemm { const bf16_t* A; const bf16_t* Bt; int M, N, K; };

struct StaticOrder {
    int nM, nN, nwg, G, c, wgm;
    __host__ __device__ void init(int M, int N, int G_, int c_, int wgm_ = 2) { nM = M / BM; nN = N / BM; nwg = nM * nN; G = G_; c = c_; wgm = wgm_; }
    __host__ __device__ bool next(int i, Unit& u) const {
        const long L = (long)i * G + c; if (L >= nwg) return false;
        int wgid = (int)L; { const int q = nwg / NXCD, r = nwg % NXCD, xcd = wgid % NXCD, off = wgid / NXCD; wgid = (xcd < r ? xcd * (q + 1) : r * (q + 1) + (xcd - r) * q) + off; }
        const int nig = wgm * nN, gid = wgid / nig, fm = gid * wgm, gsz = (nM - fm) < wgm ? (nM - fm) : wgm;
        u.pm = fm + ((wgid % nig) % gsz); u.pn = (wgid % nig) / gsz; return true;
    }
    __device__ __forceinline__ size_t b_off(const Unit&) const { return 0; }
    __device__ __forceinline__ void a_ready(const Unit&) const {}
    __device__ __forceinline__ void done(const Unit&) const {}
};
struct MoeOrder : StaticOrder {
    const PG8_LAS unsigned* tab; size_t estride;
    __device__ __forceinline__ size_t b_off(const Unit& u) const {
        const unsigned e = (unsigned)__builtin_amdgcn_readfirstlane((int)tab[u.pm]);
        return (size_t)e * estride;
    }
};

__device__ __forceinline__ unsigned cvt_pk_bf16(float lo, float hi) { unsigned r; asm volatile("v_cvt_pk_bf16_f32 %0, %1, %2" : "=v"(r) : "v"(lo), "v"(hi)); return r; }
__device__ __forceinline__ float bf_lo(unsigned w) { return __uint_as_float(w << 16); }
__device__ __forceinline__ float bf_hi(unsigned w) { return __uint_as_float(w & 0xffff0000u); }
__device__ __forceinline__ float sigmoidf_fast(float x) { return __builtin_amdgcn_rcpf(1.0f + __builtin_amdgcn_exp2f(x * -1.4426950408889634f)); }
__device__ __forceinline__ float siluf_fast(float x) { return x * sigmoidf_fast(x); }
__device__ __forceinline__ float gelu_tanh_fast(float x) { return x * sigmoidf_fast(1.5957691216057308f * (x + 0.044715f * x * x * x)); }
__device__ __forceinline__ f32x4 exp2_4(f32x4 x) { return (f32x4){__builtin_amdgcn_exp2f(x[0]), __builtin_amdgcn_exp2f(x[1]), __builtin_amdgcn_exp2f(x[2]), __builtin_amdgcn_exp2f(x[3])}; }
__device__ __forceinline__ f32x4 rcp_4(f32x4 x) { return (f32x4){__builtin_amdgcn_rcpf(x[0]), __builtin_amdgcn_rcpf(x[1]), __builtin_amdgcn_rcpf(x[2]), __builtin_amdgcn_rcpf(x[3])}; }
__device__ __forceinline__ f32x4 sigmoid_4(f32x4 x) { return rcp_4(exp2_4(x * -1.4426950408889634f) + 1.0f); }
__device__ __forceinline__ f32x4 gelu_tanh_4(f32x4 x) { return x * sigmoid_4((x * x * 0.044715f + 1.0f) * x * 1.5957691216057308f); }
constexpr float RMS_EPS = 1e-6f;
constexpr int SSQ_M = 16384;
__device__ __forceinline__ float rstd_pf(float pf) { float s = pf; s += __shfl_xor(s, 16); s += __shfl_xor(s, 32); return __builtin_amdgcn_rsqf(s * (1.0f / 1024.0f) + RMS_EPS); }
#define PG8_PF_ROWS(expr) do { _Pragma("unroll") for (int ai = 0; ai < 2; ++ai) _Pragma("unroll") for (int m = 0; m < 4; ++m) { const int row = u.pm * BM + wr * 64 + fr + ai * HALF + m * 16; pf[ai * 4 + m] = (expr); } } while (0)
__device__ __forceinline__ u32x2 pack8_fp8(const f32x4 a, const f32x4 b) {
    int lo = 0, hi = 0; lo = __builtin_amdgcn_cvt_pk_fp8_f32(a[0], a[1], lo, false); lo = __builtin_amdgcn_cvt_pk_fp8_f32(a[2], a[3], lo, true);
    hi = __builtin_amdgcn_cvt_pk_fp8_f32(b[0], b[1], hi, false); hi = __builtin_amdgcn_cvt_pk_fp8_f32(b[2], b[3], hi, true); u32x2 w; w.x = (unsigned)lo; w.y = (unsigned)hi; return w; }
constexpr float W8_SCALE = 64.0f, W8_INV = 1.0f / 64.0f;
__device__ __forceinline__ u32x4 pack8(const f32x4 a, const f32x4 b) { u32x4 w; w.x = cvt_pk_bf16(a[0], a[1]); w.y = cvt_pk_bf16(a[2], a[3]); w.z = cvt_pk_bf16(b[0], b[1]); w.w = cvt_pk_bf16(b[2], b[3]); return w; }

struct EpiEvenIn {
    static constexpr bool PERM = true, AFTER_DRAIN = false, IDEM = true;
    bf16_t* za; bf16_t* glu; const float* ssq; f32x2* lna;
    __device__ __forceinline__ void prefetch(const Unit& u, int wr, int wc, int fr, int fq, float (&pf)[8]) const { PG8_PF_ROWS(ssq[(size_t)fq * SSQ_M + row]); }
    __device__ __forceinline__ void operator()(const f32x4 (&acc)[2][2][4][2], const Unit& u, int wr, int wc, int fr, int fq, const float (&pf)[8]) const {
        const int row0 = u.pm * BM + wr * 64 + fr;
        if (u.pn < 4) {
#pragma unroll
            for (int ai = 0; ai < 2; ++ai)
#pragma unroll
                for (int m = 0; m < 4; ++m) { const int row = row0 + ai * HALF + m * 16; const float r = rstd_pf(pf[ai * 4 + m]); bf16_t* rowp = za + (size_t)row * 1024 + u.pn * 256 + wc * 32 + 8 * fq; float s = 0.f, q = 0.f;
#pragma unroll
                    for (int bj = 0; bj < 2; ++bj) { f32x4 v0 = acc[ai][bj][m][0] * r, v1 = acc[ai][bj][m][1] * r;
#pragma unroll
                        for (int j = 0; j < 1; ++j) { v0 = gelu_tanh_4(v0); v1 = gelu_tanh_4(v1); const f32x4 sv = v0 + v1, qv = v0 * v0 + v1 * v1; s += (sv[0] + sv[1]) + (sv[2] + sv[3]); q += (qv[0] + qv[1]) + (qv[2] + qv[3]); }
                        *(u32x4*)(rowp + bj * HALF) = pack8(v0, v1); }
                    if (u.pn >= 2) { s += __shfl_xor(s, 16); s += __shfl_xor(s, 32); q += __shfl_xor(q, 16); q += __shfl_xor(q, 32);
                        if (fq == 0) lna[(size_t)((u.pn - 2) * 4 + wc) * SSQ_M + row] = (f32x2){s, q}; } }
        } else {
            const int q = u.pn - 4;
#pragma unroll
            for (int ai = 0; ai < 2; ++ai)
#pragma unroll
                for (int m = 0; m < 4; ++m) { const int row = row0 + ai * HALF + m * 16; const float r = rstd_pf(pf[ai * 4 + m]); bf16_t* rowp = glu + (size_t)row * 512 + q * 128 + wc * 32 + 8 * fq;
                    f32x4 o0, o1;
#pragma unroll
                    for (int j = 0; j < 1; ++j) { o0 = (acc[ai][0][m][0] * r) * sigmoid_4(acc[ai][1][m][0] * r); o1 = (acc[ai][0][m][1] * r) * sigmoid_4(acc[ai][1][m][1] * r); }
                    *(u32x4*)rowp = pack8(o0, o1); }
        }
    }
};
struct EpiOddIn {
    static constexpr bool PERM = true, AFTER_DRAIN = false, IDEM = true;
    bf16_t* gb; bf16_t* cv; const float* ssq;
    __device__ __forceinline__ void prefetch(const Unit& u, int wr, int wc, int fr, int fq, float (&pf)[8]) const { PG8_PF_ROWS(ssq[(size_t)fq * SSQ_M + row]); }
    __device__ __forceinline__ void operator()(const f32x4 (&acc)[2][2][4][2], const Unit& u, int wr, int wc, int fr, int fq, const float (&pf)[8]) const {
        const int row0 = u.pm * BM + wr * 64 + fr;
        if (u.pn < 4) {
#pragma unroll
            for (int ai = 0; ai < 2; ++ai)
#pragma unroll
                for (int m = 0; m < 4; ++m) { const int row = row0 + ai * HALF + m * 16; const float r = rstd_pf(pf[ai * 4 + m]); bf16_t* rowp = gb + (size_t)row * 1024 + u.pn * 256 + wc * 32 + 8 * fq;
#pragma unroll
                    for (int bj = 0; bj < 2; ++bj) *(u32x4*)(rowp + bj * HALF) = pack8(acc[ai][bj][m][0] * r, acc[ai][bj][m][1] * r); }
        } else {
            const int q = u.pn - 4;
#pragma unroll
            for (int ai = 0; ai < 2; ++ai)
#pragma unroll
                for (int m = 0; m < 4; ++m) { const int row = row0 + ai * HALF + m * 16; const float r = rstd_pf(pf[ai * 4 + m]), r2 = r * r; bf16_t* rowp = cv + (size_t)row * 1024 + q * 128 + wc * 32 + 8 * fq;
                    *(u32x4*)rowp = pack8(acc[ai][0][m][0] * acc[ai][1][m][0] * r2, acc[ai][0][m][1] * acc[ai][1][m][1] * r2); }
        }
    }
};
template <bool DIRECT, bool OUT8> struct EpiGlu {
    static constexpr bool PERM = true, AFTER_DRAIN = false, IDEM = true;
    void* out; int ldo; const float* rs; float sc;
    __device__ __forceinline__ void prefetch(const Unit& u, int wr, int wc, int fr, int fq, float (&pf)[8]) const { PG8_PF_ROWS(DIRECT ? rs[row] : rs[(size_t)fq * SSQ_M + row]); }
    __device__ __forceinline__ void operator()(const f32x4 (&acc)[2][2][4][2], const Unit& u, int wr, int wc, int fr, int fq, const float (&pf)[8]) const {
        const int row0 = u.pm * BM + wr * 64 + fr;
#pragma unroll
        for (int ai = 0; ai < 2; ++ai)
#pragma unroll
            for (int m = 0; m < 4; ++m) { const int row = row0 + ai * HALF + m * 16; const float r = (DIRECT ? pf[ai * 4 + m] : rstd_pf(pf[ai * 4 + m])) * sc; const size_t off = (size_t)row * ldo + u.pn * 128 + wc * 32 + 8 * fq;
                f32x4 o0, o1;
#pragma unroll
                for (int j = 0; j < 1; ++j) { const f32x4 t0 = acc[ai][0][m][0] * r, t1 = acc[ai][0][m][1] * r; o0 = (t0 * sigmoid_4(t0)) * (acc[ai][1][m][0] * r); o1 = (t1 * sigmoid_4(t1)) * (acc[ai][1][m][1] * r); }
                if constexpr (OUT8) *(u32x2*)((unsigned char*)out + off) = pack8_fp8(o0, o1); else *(u32x4*)((bf16_t*)out + off) = pack8(o0, o1); }
    }
};
template <bool X8> struct EpiRes {
    static constexpr bool PERM = true, AFTER_DRAIN = false, IDEM = false;
    bf16_t* xb; float* ssq_out; float sc; unsigned char* x8; PG8_LAS float* red;
    __device__ __forceinline__ void prefetch(const Unit&, int, int, int, int, float (&)[8]) const {}
    __device__ __forceinline__ void operator()(const f32x4 (&acc)[2][2][4][2], const Unit& u, int wr, int wc, int fr, int fq, const float (&pf)[8]) const {
        const int row0 = u.pm * BM + wr * 64 + fr;
#pragma unroll
        for (int ai = 0; ai < 2; ++ai)
#pragma unroll
            for (int m = 0; m < 4; ++m) { const int row = row0 + ai * HALF + m * 16; const size_t off = (size_t)row * 1024 + u.pn * 256 + wc * 32 + 8 * fq; bf16_t* rowp = xb + off; float s = 0.f;
#pragma unroll
                for (int bj = 0; bj < 2; ++bj) { const u32x4 old = *(const u32x4*)(rowp + bj * HALF); const f32x4 a0 = acc[ai][bj][m][0] * sc, a1 = acc[ai][bj][m][1] * sc;
                    f32x4 n0, n1; n0[0] = bf_lo(old.x) + a0[0]; n0[1] = bf_hi(old.x) + a0[1]; n0[2] = bf_lo(old.y) + a0[2]; n0[3] = bf_hi(old.y) + a0[3];
                    n1[0] = bf_lo(old.z) + a1[0]; n1[1] = bf_hi(old.z) + a1[1]; n1[2] = bf_lo(old.w) + a1[2]; n1[3] = bf_hi(old.w) + a1[3];
                    s += (n0[0] * n0[0] + n0[1] * n0[1]) + (n0[2] * n0[2] + n0[3] * n0[3]) + (n1[0] * n1[0] + n1[1] * n1[1]) + (n1[2] * n1[2] + n1[3] * n1[3]);
                    *(u32x4*)(rowp + bj * HALF) = pack8(n0, n1);
                    if constexpr (X8) *(u32x2*)(x8 + off + bj * HALF) = pack8_fp8(n0, n1); }
                s += __shfl_xor(s, 16); s += __shfl_xor(s, 32);
                if (fq == 0) red[(ai * HALF + wr * 64 + m * 16 + fr) * 4 + wc] = s; }
        asm volatile("s_waitcnt lgkmcnt(0)" ::: "memory"); __builtin_amdgcn_s_barrier(); asm volatile("" ::: "memory");
        { const int l = fr + 16 * fq; if (l < 32) { const int q = wc * 32 + l, rl = (q >> 6) * HALF + wr * 64 + (q & 63); const f32x4 v = *(const PG8_LAS f32x4*)(red + rl * 4);
            ssq_out[(size_t)u.pn * SSQ_M + u.pm * BM + rl] = (v[0] + v[1]) + (v[2] + v[3]); } }
    }
};
struct EpiMoeDown {
    static constexpr bool PERM = true, AFTER_DRAIN = false, IDEM = true;
    bf16_t* og; const float* gate; float sc;
    __device__ __forceinline__ void prefetch(const Unit& u, int wr, int wc, int fr, int fq, float (&pf)[8]) const { PG8_PF_ROWS(gate[row]); }
    __device__ __forceinline__ void operator()(const f32x4 (&acc)[2][2][4][2], const Unit& u, int wr, int wc, int fr, int fq, const float (&pf)[8]) const {
        const int row0 = u.pm * BM + wr * 64 + fr;
#pragma unroll
        for (int ai = 0; ai < 2; ++ai)
#pragma unroll
            for (int m = 0; m < 4; ++m) { const int row = row0 + ai * HALF + m * 16; const float r = pf[ai * 4 + m] * sc; bf16_t* rowp = og + (size_t)row * 1024 + u.pn * 256 + wc * 32 + 8 * fq;
#pragma unroll
                for (int bj = 0; bj < 2; ++bj) *(u32x4*)(rowp + bj * HALF) = pack8(acc[ai][bj][m][0] * r, acc[ai][bj][m][1] * r); }
    }
};

template <class Epi, class Sched, bool ALIGN_EPI = false, bool SP2 = false, bool F8 = false>
__device__ __forceinline__ void gemm_phase(PG8_LAS unsigned char* lds, const Gemm g, const Sched& S, const Epi& E) {
    int tid_ = threadIdx.x; asm volatile("" : "+v"(tid_));
    const int tid = tid_, wid = __builtin_amdgcn_readfirstlane(tid >> 6), lane = tid & 63, wr = wid >> 2, wc = wid & 3, fr = lane & 15, fq = lane >> 4;
    const int K = F8 ? g.K / 2 : g.K, nt = K / BK;
    unsigned voffA[2], voffB[2];
#pragma unroll
    for (int i = 0; i < 2; ++i) { int R, C; stage_rc(tid * 16 + i * 8192, R, C); const int Rb = Epi::PERM ? ((R & ~31) + perm32(R & 31)) : R;
        voffA[i] = (unsigned)(R * K + C) * 2u; voffB[i] = (unsigned)(Rb * K + C) * 2u; }
    const size_t kstep = (size_t)(BK * 2);
    const size_t hstep = (size_t)HALF * K * 2;
    const size_t tstep = 2 * hstep;
    const unsigned ldsw = (unsigned)wid * 1024u;
    const int aoff = lds_byte(wr * 64 + fr, fq * 8), boff = lds_byte(wc * 32 + fr, fq * 8);
#define PG8_SA(b, h) (((b) * 2 + (h)) * HTB)
#define PG8_SB(b, h) ((4 + (b) * 2 + (h)) * HTB)
#define PG8_STAGE(bufoff, gbase, voff) do { _Pragma("unroll") for (int _i = 0; _i < 2; ++_i) \
        __builtin_amdgcn_global_load_lds((const unsigned*)((const char*)(gbase) + (voff)[_i]), (PG8_LAS unsigned*)(lds + (bufoff) + ldsw + _i * 8192), 16, 0, 0); } while (0)
#define PG8_LD16(off) (*(const PG8_LAS v4i32*)(lds + (off)))
#define PG8_LDA(dst, b, h) do { if constexpr (F8) { _Pragma("unroll") for (int m = 0; m < 4; ++m) dst##8[m] = __builtin_shufflevector(PG8_LD16(PG8_SA(b, h) + aoff + m * 2048), PG8_LD16(PG8_SA(b, h) + aoff + m * 2048 + 1024), 0, 1, 2, 3, 4, 5, 6, 7); } \
        else { _Pragma("unroll") for (int m = 0; m < 4; ++m) _Pragma("unroll") for (int k = 0; k < 2; ++k) dst[m][k] = *(const PG8_LAS bf16x8*)(lds + PG8_SA(b, h) + aoff + m * 2048 + k * 1024); } } while (0)
#define PG8_LDB(dst, b, h) do { if constexpr (F8) { _Pragma("unroll") for (int n = 0; n < 2; ++n) dst##8[n] = __builtin_shufflevector(PG8_LD16(PG8_SB(b, h) + boff + n * 2048), PG8_LD16(PG8_SB(b, h) + boff + n * 2048 + 1024), 0, 1, 2, 3, 4, 5, 6, 7); } \
        else { _Pragma("unroll") for (int n = 0; n < 2; ++n) _Pragma("unroll") for (int k = 0; k < 2; ++k) dst[n][k] = *(const PG8_LAS bf16x8*)(lds + PG8_SB(b, h) + boff + n * 2048 + k * 1024); } } while (0)
#define PG8_MMA(ai, bj, At, Bt) do { __builtin_amdgcn_s_setprio(1); \
        if constexpr (F8) { _Pragma("unroll") for (int m = 0; m < 4; ++m) _Pragma("unroll") for (int n = 0; n < 2; ++n) \
            asm volatile("v_mfma_f32_16x16x128_f8f6f4 %0, %1, %2, %0" : "+v"(acc[ai][bj][m][n]) : "v"(Bt##8[n]), "v"(At##8[m])); } \
        else { _Pragma("unroll") for (int m = 0; m < 4; ++m) _Pragma("unroll") for (int n = 0; n < 2; ++n) _Pragma("unroll") for (int k = 0; k < 2; ++k) \
            acc[ai][bj][m][n] = __builtin_amdgcn_mfma_f32_16x16x32_bf16(Bt[n][k], At[m][k], acc[ai][bj][m][n], 0, 0, 0); } \
        __builtin_amdgcn_s_setprio(0); } while (0)
#define PG8_WAIT_V(n) asm volatile("s_waitcnt vmcnt(" #n ")" ::: "memory")
#define PG8_WAIT_L(n) asm volatile("s_waitcnt lgkmcnt(" #n ")" ::: "memory")
#define PG8_BAR __builtin_amdgcn_s_barrier()
#define PG8_SCHED __builtin_amdgcn_sched_barrier(0)
    Unit cur, nxt; int ui = 0;
    if (!S.next(0, cur)) return;
    f32x4 acc[2][2][4][2];
#pragma unroll
    for (int a = 0; a < 2; ++a)
#pragma unroll
        for (int b = 0; b < 2; ++b)
#pragma unroll
            for (int m = 0; m < 4; ++m)
#pragma unroll
                for (int n = 0; n < 2; ++n) acc[a][b][m][n] = (f32x4){0.f, 0.f, 0.f, 0.f};
    float pf[8] = {0.f, 0.f, 0.f, 0.f, 0.f, 0.f, 0.f, 0.f};
    bf16x8 At[4][2], B0[2][2], B1[2][2]; v8i32 At8[4], B08[2], B18[2];
    const char* cA = (const char*)g.A + (size_t)cur.pm * tstep; const char* cB = (const char*)g.Bt + S.b_off(cur) + (size_t)cur.pn * tstep;
    S.a_ready(cur);
    if constexpr (SP2) {
        PG8_STAGE(PG8_SB(0, 0), cB, voffB); PG8_STAGE(PG8_SB(0, 1), cB + hstep, voffB); PG8_STAGE(PG8_SA(0, 0), cA, voffA); PG8_STAGE(PG8_SA(0, 1), cA + hstep, voffA);
        if (wr == 1) PG8_BAR;
        PG8_WAIT_V(2); PG8_BAR;
        PG8_STAGE(PG8_SB(1, 0), cB + kstep, voffB); PG8_STAGE(PG8_SA(1, 0), cA + kstep, voffA); PG8_STAGE(PG8_SB(1, 1), cB + hstep + kstep, voffB);
        PG8_WAIT_V(6); PG8_BAR;
    } else {
        PG8_STAGE(PG8_SB(0, 0), cB, voffB); PG8_STAGE(PG8_SA(0, 0), cA, voffA); PG8_STAGE(PG8_SB(0, 1), cB + hstep, voffB); PG8_STAGE(PG8_SA(0, 1), cA + hstep, voffA);
        if (wr == 1) PG8_BAR;
        PG8_WAIT_V(4); PG8_BAR;
        PG8_STAGE(PG8_SB(1, 0), cB + kstep, voffB); PG8_STAGE(PG8_SA(1, 0), cA + kstep, voffA); PG8_STAGE(PG8_SB(1, 1), cB + hstep + kstep, voffB);
        PG8_WAIT_V(6); PG8_BAR;
    }
    for (;;) {
        const bool has_next = S.next(ui + 1, nxt);
        const char* nA = has_next ? (const char*)g.A + (size_t)nxt.pm * tstep : cA; const char* nB = has_next ? (const char*)g.Bt + S.b_off(nxt) + (size_t)nxt.pn * tstep : cB;
        for (int t = 0; t < nt; t += 2) {
            const bool last = (t == nt - 2);
            const char* a1 = cA + (size_t)(t + 1) * kstep;
            const char* a2 = last ? nA : cA + (size_t)(t + 2) * kstep; const char* b2 = last ? nB : cB + (size_t)(t + 2) * kstep;
            const char* a3 = a2 + kstep; const char* b3 = b2 + kstep;
            if (last) E.prefetch(cur, wr, wc, fr, fq, pf);
            if (last && has_next) S.a_ready(nxt);
            if constexpr (SP2) {
            PG8_LDB(B0, 0, 0); PG8_LDB(B1, 0, 1); PG8_SCHED; PG8_LDA(At, 0, 0); PG8_STAGE(PG8_SA(1, 1), a1 + hstep, voffA);
            PG8_WAIT_V(8); PG8_WAIT_L(0); PG8_BAR; PG8_MMA(0, 0, At, B0); PG8_MMA(0, 1, At, B1); PG8_BAR; PG8_SCHED;
            PG8_LDA(At, 0, 1); PG8_STAGE(PG8_SB(0, 0), b2, voffB); PG8_STAGE(PG8_SB(0, 1), b2 + hstep, voffB); PG8_STAGE(PG8_SA(0, 0), a2, voffA);
            PG8_WAIT_V(8); PG8_WAIT_L(0); PG8_BAR; PG8_MMA(1, 0, At, B0); PG8_MMA(1, 1, At, B1); PG8_BAR; PG8_SCHED;
            PG8_LDB(B0, 1, 0); PG8_LDB(B1, 1, 1); PG8_SCHED; PG8_LDA(At, 1, 0); PG8_STAGE(PG8_SA(0, 1), a2 + hstep, voffA);
            PG8_WAIT_V(8); PG8_WAIT_L(0); PG8_BAR; PG8_MMA(0, 0, At, B0); PG8_MMA(0, 1, At, B1); PG8_BAR; PG8_SCHED;
            PG8_LDA(At, 1, 1); PG8_STAGE(PG8_SB(1, 0), b3, voffB); PG8_STAGE(PG8_SB(1, 1), b3 + hstep, voffB); PG8_STAGE(PG8_SA(1, 0), a3, voffA);
            PG8_WAIT_V(8); PG8_WAIT_L(0); PG8_BAR; PG8_MMA(1, 0, At, B0); PG8_MMA(1, 1, At, B1); PG8_BAR; PG8_SCHED;
            } else {
            PG8_LDB(B0, 0, 0); PG8_SCHED; PG8_LDA(At, 0, 0); PG8_STAGE(PG8_SA(1, 1), a1 + hstep, voffA);
            PG8_WAIT_L(8); PG8_BAR; PG8_WAIT_L(0); PG8_MMA(0, 0, At, B0); PG8_BAR; PG8_SCHED;
            PG8_LDB(B1, 0, 1); PG8_STAGE(PG8_SB(0, 0), b2, voffB);
            PG8_BAR; PG8_WAIT_L(0); PG8_MMA(0, 1, At, B1); PG8_BAR;
            PG8_LDA(At, 0, 1); PG8_STAGE(PG8_SA(0, 0), a2, voffA);
            PG8_BAR; PG8_WAIT_L(0); PG8_MMA(1, 0, At, B0); PG8_BAR; PG8_SCHED;
            PG8_STAGE(PG8_SB(0, 1), b2 + hstep, voffB);
            PG8_WAIT_V(6); PG8_BAR; PG8_MMA(1, 1, At, B1); PG8_BAR;
            PG8_LDB(B0, 1, 0); PG8_SCHED; PG8_LDA(At, 1, 0); PG8_STAGE(PG8_SA(0, 1), a2 + hstep, voffA);
            PG8_WAIT_L(8); PG8_BAR; PG8_WAIT_L(0); PG8_MMA(0, 0, At, B0); PG8_BAR; PG8_SCHED;
            PG8_LDB(B1, 1, 1); PG8_STAGE(PG8_SB(1, 0), b3, voffB);
            PG8_BAR; PG8_WAIT_L(0); PG8_MMA(0, 1, At, B1); PG8_BAR;
            PG8_LDA(At, 1, 1); PG8_STAGE(PG8_SA(1, 0), a3, voffA);
            PG8_BAR; PG8_WAIT_L(0); PG8_MMA(1, 0, At, B0); PG8_BAR; PG8_SCHED;
            PG8_STAGE(PG8_SB(1, 1), b3 + hstep, voffB);
            PG8_WAIT_V(6); PG8_BAR; PG8_MMA(1, 1, At, B1); PG8_BAR;
            }
        }
        if constexpr (ALIGN_EPI) { if (wr == 0) PG8_BAR; }
        if constexpr (F8) {
#define PG8_A4(a, b) "+v"(acc[a][b][0][0]), "+v"(acc[a][b][0][1]), "+v"(acc[a][b][1][0]), "+v"(acc[a][b][1][1]), "+v"(acc[a][b][2][0]), "+v"(acc[a][b][2][1]), "+v"(acc[a][b][3][0]), "+v"(acc[a][b][3][1])
            asm volatile("s_nop 15\n\ts_nop 7" : PG8_A4(0, 0), PG8_A4(0, 1));
            asm volatile("" : PG8_A4(1, 0), PG8_A4(1, 1));
#undef PG8_A4
        }
        if constexpr (!Epi::AFTER_DRAIN) { E(acc, cur, wr, wc, fr, fq, pf);
#ifdef EPI_TWICE
            if constexpr (Epi::IDEM) { asm volatile("" ::: "memory"); E(acc, cur, wr, wc, fr, fq, pf); }
#endif
            S.done(cur); }
        if (!has_next) break;
#pragma unroll
        for (int a = 0; a < 2; ++a)
#pragma unroll
            for (int b = 0; b < 2; ++b)
#pragma unroll
                for (int m = 0; m < 4; ++m)
#pragma unroll
                    for (int n = 0; n < 2; ++n) acc[a][b][m][n] = (f32x4){0.f, 0.f, 0.f, 0.f};
        cur = nxt; cA = nA; cB = nB; ++ui;
        if constexpr (ALIGN_EPI) { if (wr == 1) PG8_BAR; }
    }
    PG8_WAIT_V(0);
    if constexpr (!ALIGN_EPI) { if (wr == 0) PG8_BAR; }
    PG8_BAR;
    if constexpr (Epi::AFTER_DRAIN) { E.fused(acc, cur, wr, wc, fr, fq, lds, wid, lane); S.done(cur); }
#undef PG8_SA
#undef PG8_SB
#undef PG8_STAGE
#undef PG8_LD16
#undef PG8_LDA
#undef PG8_LDB
#undef PG8_MMA
#undef PG8_WAIT_V
#undef PG8_WAIT_L
#undef PG8_BAR
#undef PG8_SCHED
}
}

constexpr int NWAVES = 8;
#ifndef MK_PER_PHASE
#define MK_PER_PHASE 0
#endif
#ifndef MOE_FP8
#define MOE_FP8 1
#endif
#ifndef FFN2_FP8
#define FFN2_FP8 1
#endif
#ifndef FILL_TAILS
#define FILL_TAILS 1
#endif
#ifndef EPI_ALIGN_HEAVY
#define EPI_ALIGN_HEAVY true
#endif
#ifndef F8_SP2
#define F8_SP2 true
#endif
#ifndef WGM_E1
#define WGM_E1 2
#endif
#ifndef WGM_E4
#define WGM_E4 2
#endif
#ifndef WGM_O1
#define WGM_O1 2
#endif
#ifndef WGM_O6
#define WGM_O6 2
#endif
#ifndef WGM_O7
#define WGM_O7 2
#endif
#ifndef WGM_N4
#define WGM_N4 2
#endif
#ifndef MK_LAST_PHASE
#define MK_LAST_PHASE 26
#endif

constexpr int M = 16384, D = 1024, SEQ = 8192, DFF = 2816, NE = 8, NFF2 = 2 * DFF;
constexpr int EV_IN = 2048, OD_IN = 3072, AW = 512, BW = 512, CHUNK = 128, KB = 31;
constexpr int MAXP = 136, MSLOT = MAXP * 256;
constexpr float LN_EPS = 1e-5f;
constexpr int NPHASE = 27;

constexpr size_t MiB = 1u << 20;
constexpr size_t WS_CTL = 0, CTL_ZERO_BYTES = 64 * 1024;
constexpr size_t WS_MISC = 2 * MiB;
constexpr size_t MI_RT = 0, MI_WSB = 64 * 1024, MI_TOKE = 512 * 1024, MI_TOKG = 640 * 1024, MI_TOKR = 768 * 1024, MI_TOKS = 896 * 1024,
                 MI_CNT = 1024 * 1024, MI_LNA = 2048 * 1024  , MI_TOKRS = 1472 * 1024, MI_HDR = 1040 * 1024, MI_RSG = 1088 * 1024, MI_GTG = 1280 * 1024;
constexpr size_t WS_SSQ = 6 * MiB;
constexpr size_t WS_WEV = 14 * MiB, EV_BYTES = 23 * MiB;
constexpr size_t EVO_WIN = 0, EVO_WOUT = 4 * MiB, EVO_W13 = 6 * MiB, EVO_W2 = 17 * MiB;
constexpr size_t WS_WOD = WS_WEV + 2 * EV_BYTES, OD_BYTES = 140 * MiB;
constexpr size_t ODO_WIN = 0, ODO_WOUT = 6 * MiB, ODO_W13 = 8 * MiB, ODO_W2 = 96 * MiB;
constexpr size_t WS_XB = WS_WOD + 2 * OD_BYTES;
constexpr size_t WS_R1 = WS_XB + 32 * MiB;
constexpr size_t WS_R2 = WS_R1 + 68 * MiB;
constexpr size_t WS_R3 = WS_R2 + 68 * MiB;
constexpr size_t WS_END = WS_R3 + 187 * MiB;
static_assert((size_t)MSLOT * D * 2 <= 68 * MiB && (size_t)MSLOT * DFF * 2 <= 187 * MiB && (size_t)M * DFF * 2 <= 187 * MiB, "d_ws map");
constexpr int CW_TMO = 0, CW_CODE = 1;
constexpr int CW_FILL = 2048;
constexpr int CW_BAR = 4096;

constexpr int RING_BYTES = 131072;
constexpr int LDS_BYTES = 147456;
constexpr int RED_OFF = RING_BYTES;
constexpr int PTAB_OFF = LDS_BYTES - 2048;
constexpr int MISC_OFF = LDS_BYTES - 512;

#define GAS __attribute__((address_space(1)))
#define LAS __attribute__((address_space(3)))
typedef unsigned short bf16;
typedef unsigned v4u __attribute__((ext_vector_type(4)));
typedef unsigned v2u __attribute__((ext_vector_type(2)));
typedef float f32x4 __attribute__((ext_vector_type(4)));
typedef float f32x2 __attribute__((ext_vector_type(2)));
typedef short bf16x8 __attribute__((ext_vector_type(8)));
typedef GAS unsigned gu32;
#define RLX_AGENT __ATOMIC_RELAXED, __HIP_MEMORY_SCOPE_AGENT
#define LDS_WAIT() asm volatile("s_waitcnt lgkmcnt(0)" ::: "memory")
#define VM_WAIT() asm volatile("s_waitcnt vmcnt(0)" ::: "memory")
using pg8::cvt_pk_bf16; using pg8::bf_lo; using pg8::bf_hi; using pg8::sigmoidf_fast; using pg8::siluf_fast; using pg8::RMS_EPS;

#define XB_TMO      128
#define XB_XCNT(j)  (256  + 64 * (j))
#define XB_XSUB(j)  (1280 + 64 * (j))
#define XB_XGEN(j)  (2304 + 64 * (j))
#define XB_TOP      3328
#define XB_TOPGEN   3392
#define XCD_BAR_WORDS 3456
#define XB_SPIN_CAP (1u << 18)

__device__ __forceinline__ unsigned xb_ld(unsigned* p)              { return __hip_atomic_load(p, __ATOMIC_RELAXED, __HIP_MEMORY_SCOPE_AGENT); }
__device__ __forceinline__ unsigned xb_add(unsigned* p, unsigned v) { return __hip_atomic_fetch_add(p, v, __ATOMIC_RELAXED, __HIP_MEMORY_SCOPE_AGENT); }
__device__ __forceinline__ unsigned xb_xcc_id() { return (unsigned)__builtin_amdgcn_s_getreg((3 << 11) | 20) & 0xFu; }
#define XB_SPIN(cond, bar) do { unsigned _sp = 0; while (cond) { __builtin_amdgcn_s_sleep(1); \
    if ((++_sp & 255u) == 0u) { if (xb_ld(&(bar)[XB_TMO])) break; if (_sp > XB_SPIN_CAP) { atomicAdd(&(bar)[XB_TMO], 1u); break; } } } } while (0)

struct XcdBarrier {
    unsigned* bar; unsigned x;
    volatile LAS unsigned* st;
};

__device__ __forceinline__ XcdBarrier xcd_barrier_post(unsigned* bar, volatile LAS unsigned* st) {
    XcdBarrier b; b.bar = bar; b.x = xb_xcc_id(); b.st = st;
    if (threadIdx.x == 0) (void)xb_add(&bar[XB_XCNT(b.x)], 1u);
    return b;
}
__device__ __forceinline__ void xcd_barrier_complete(unsigned* bar, unsigned x, unsigned& nloc, unsigned& nx) {
    const unsigned G = gridDim.x * gridDim.y * gridDim.z;
    unsigned sum, cnt, mine, sp = 0u;
    for (;;) {
        sum = 0u; cnt = 0u; mine = 0u;
#pragma unroll
        for (unsigned j = 0; j < 16; ++j) { const unsigned c = xb_ld(&bar[XB_XCNT(j)]); sum += c; cnt += (c > 0u) ? 1u : 0u; mine = (j == x) ? c : mine; }
        if (sum == G) break;
        __builtin_amdgcn_s_sleep(1);
        if ((++sp & 255u) == 0u) { if (xb_ld(&bar[XB_TMO])) break; if (sp > XB_SPIN_CAP) { atomicAdd(&bar[XB_TMO], 1u); break; } }
    }
    nloc = mine > 0u ? mine : 1u; nx = cnt > 0u ? cnt : 1u;
}

__device__ __forceinline__ void xcd_barrier(const XcdBarrier& b) {
    asm volatile("s_waitcnt vmcnt(0)" ::: "memory");
    __syncthreads();
    if (threadIdx.x == 0) {
        unsigned* bar = b.bar;
        __builtin_amdgcn_s_waitcnt(0);
        unsigned nloc = b.st[0], nx = b.st[1];
        if (nloc == 0u) { xcd_barrier_complete(bar, b.x, nloc, nx); b.st[0] = nloc; b.st[1] = nx; }
        const unsigned old = xb_add(&bar[XB_XSUB(b.x)], 1u);
        const unsigned gen = old / nloc;
        if (old + 1u == (gen + 1u) * nloc) {
            __builtin_amdgcn_fence(__ATOMIC_RELEASE, "agent");
            asm volatile("s_waitcnt vmcnt(0)" ::: "memory");
            const unsigned og = xb_add(&bar[XB_TOP], 1u);
            const unsigned tg = og / nx;
            if (og + 1u == (tg + 1u) * nx) xb_add(&bar[XB_TOPGEN], 1u);
            else XB_SPIN(xb_ld(&bar[XB_TOPGEN]) == tg, bar);
            __builtin_amdgcn_fence(__ATOMIC_ACQUIRE, "agent");
            xb_add(&bar[XB_XGEN(b.x)], 1u);
            asm volatile("s_waitcnt vmcnt(0)" ::: "memory");
        } else {
            XB_SPIN(xb_ld(&bar[XB_XGEN(b.x)]) == gen, bar);
            __builtin_amdgcn_fence(__ATOMIC_ACQUIRE, "agent");
            asm volatile("s_waitcnt vmcnt(0)" ::: "memory");
        }
    }
    __syncthreads();
}

typedef const float* fptr_t;
typedef __attribute__((address_space(4))) const fptr_t* intab_t;
struct Frame {
    LAS unsigned char* lds;
    volatile LAS unsigned* MISC;
    gu32* ctl;
    GAS unsigned char* ws;
    int tid, lane, wave;
    int vcu, G;
    intab_t in; float* out;
};
__device__ __forceinline__ float wave_sum(float v) {
#pragma unroll
    for (int o = 1; o < 64; o <<= 1) v += __shfl_xor(v, o);
    return v;
}
__device__ __forceinline__ int opaque_v(int x) { asm volatile("" : "+v"(x)); return x; }
__device__ __forceinline__ int opaque_s(int x) { asm volatile("" : "+s"(x)); return x; }
__device__ __forceinline__ intab_t opaque_tab(intab_t p) { asm volatile("" : "+s"(p)); return p; }
__device__ __forceinline__ bf16* ev_w(Frame& F, int lp, size_t off) { return (bf16*)(F.ws + WS_WEV + (size_t)lp * EV_BYTES + off); }
__device__ __forceinline__ bf16* od_w(Frame& F, int lp, size_t off) { return (bf16*)(F.ws + WS_WOD + (size_t)lp * OD_BYTES + off); }
__device__ __forceinline__ bf16* ev_wl(GAS unsigned char* ws, int lp, size_t off) { return (bf16*)(ws + WS_WEV + (size_t)lp * EV_BYTES + off); }
__device__ __forceinline__ bf16* od_wl(GAS unsigned char* ws, int lp, size_t off) { return (bf16*)(ws + WS_WOD + (size_t)lp * OD_BYTES + off); }
__device__ __forceinline__ float* ssq_arr(Frame& F, int s) { return (float*)(F.ws + WS_SSQ) + (size_t)s * 4 * M; }
__device__ __forceinline__ float rstd_wave(const float* part, int row, int lane) { float s = (lane < 4) ? part[(size_t)lane * M + row] : 0.f; s = wave_sum(s); return __builtin_amdgcn_rsqf(s * (1.0f / 1024.0f) + RMS_EPS); }
__device__ __forceinline__ void ssq_store_row(float* part, int row, int lane, float s) { if (lane < 4) part[(size_t)lane * M + row] = (lane == 0) ? s : 0.f; }

__device__ __forceinline__ int p0_drow(int mode, int which, int n0) {
    if (mode == 0) return n0;
    if (mode == 1) return (n0 >> 7) * 256 + which * 128 + (n0 & 127);
    if (n0 < 1024) return n0;
    const int m = n0 - 1024, half = (mode == 2) ? 512 : 1024, w = m / half, mm = m % half;
    return 1024 + (mm >> 7) * 256 + w * 128 + (mm & 127);
}
struct P0Item { const float* src; const float* gsrc; bf16* dst; int N; int f8; };
constexpr int P0_I_EV = 5760, P0_I_OD = 35840, P0_I_PAIR = P0_I_EV + P0_I_OD, P0_NITEMS = 2 * P0_I_PAIR;
__device__ __forceinline__ P0Item p0_decode(Frame& F, int it, int lane) {
    const int lp = it / P0_I_PAIR; int r = it % P0_I_PAIR;
    const float* W; const float* gain = nullptr; bf16* WT; int K = 1024, N, mode = 0, which = 0, f8 = 0;
    if (r < P0_I_EV) {
        if (r < 1024)      { W = F.in[3] + (size_t)lp * 1024 * 2048; N = 2048; gain = F.in[1] + (2 * lp) * 1024; WT = ev_w(F, lp, EVO_WIN); mode = 2; }
        else if (r < 1536) { r -= 1024; W = F.in[12] + (size_t)lp * 1024 * 1024; N = 1024; WT = ev_w(F, lp, EVO_WOUT); }
        else if (r < 2944) { f8 = (FFN2_FP8 && lp == 1); r -= 1536; W = F.in[16] + (size_t)lp * 1024 * DFF; N = DFF; gain = F.in[2] + (2 * lp) * 1024; WT = ev_w(F, lp, EVO_W13); mode = 1; which = 0; }
        else if (r < 4352) { f8 = (FFN2_FP8 && lp == 1); r -= 2944; W = F.in[17] + (size_t)lp * 1024 * DFF; N = DFF; gain = F.in[2] + (2 * lp) * 1024; WT = ev_w(F, lp, EVO_W13); mode = 1; which = 1; }
        else               { f8 = (FFN2_FP8 && lp == 1); r -= 4352; W = F.in[18] + (size_t)lp * DFF * 1024; N = 1024; K = DFF; WT = ev_w(F, lp, EVO_W2); }
    } else {
        r -= P0_I_EV;
        if (r < 1536)      { W = F.in[13] + (size_t)lp * 1024 * 3072; N = 3072; gain = F.in[1] + (2 * lp + 1) * 1024; WT = od_w(F, lp, ODO_WIN); mode = 3; }
        else if (r < 2048) { r -= 1536; W = F.in[15] + (size_t)lp * 1024 * 1024; N = 1024; WT = od_w(F, lp, ODO_WOUT); }
        else { r -= 2048; const int e = r / 4224, q = r % 4224, t = q / 1408; r = q % 1408; const size_t le = (size_t)(lp * NE + e); f8 = MOE_FP8;
            if (t == 0)      { W = F.in[20] + le * 1024 * DFF; N = DFF; gain = F.in[2] + (2 * lp + 1) * 1024; WT = (bf16*)((unsigned char*)od_w(F, lp, ODO_W13) + (size_t)e * NFF2 * 1024 * (MOE_FP8 ? 1 : 2)); mode = 1; which = 0; }
            else if (t == 1) { W = F.in[21] + le * 1024 * DFF; N = DFF; gain = F.in[2] + (2 * lp + 1) * 1024; WT = (bf16*)((unsigned char*)od_w(F, lp, ODO_W13) + (size_t)e * NFF2 * 1024 * (MOE_FP8 ? 1 : 2)); mode = 1; which = 1; }
            else             { W = F.in[22] + le * DFF * 1024; N = 1024; K = DFF; WT = (bf16*)((unsigned char*)od_w(F, lp, ODO_W2) + (size_t)e * 1024 * DFF * (MOE_FP8 ? 1 : 2)); } }
    }
    const int nblk = N / 32, kb = r / nblk, nb = r % nblk, k0 = 64 * kb, n0 = 32 * nb;
    P0Item p; p.N = N; p.f8 = f8;
    p.src = W + (size_t)(k0 + (lane >> 3)) * N + n0 + 4 * (lane & 7);
    p.gsrc = gain ? gain + k0 + (lane >> 3) : nullptr;
    { const size_t eoff = (size_t)(p0_drow(mode, which, n0) + (lane >> 1)) * K + k0 + 32 * (lane & 1); p.dst = f8 ? (bf16*)((unsigned char*)WT + eoff) : WT + eoff; }
    return p;
}
__device__ __forceinline__ void p0_load(const P0Item& p, f32x4 (&v)[8], float (&g)[8]) {
#pragma unroll
    for (int i = 0; i < 8; ++i) { v[i] = __builtin_nontemporal_load((const GAS f32x4*)(p.src + (size_t)(8 * i) * p.N)); g[i] = p.gsrc ? p.gsrc[8 * i] : 1.0f; }
}
__device__ __forceinline__ void p0_store(const P0Item& p, const f32x4 (&v)[8], const float (&g)[8], LAS float* T, int lane) {
    const int r = lane >> 3, c4 = lane & 7;
#pragma unroll
    for (int i = 0; i < 8; ++i)
#pragma unroll
        for (int j = 0; j < 4; ++j) T[(4 * c4 + j) * 68 + 8 * i + r] = v[i][j] * g[i];
    LDS_WAIT(); asm volatile("" ::: "memory");
    const LAS f32x4* row = (const LAS f32x4*)(T + (lane >> 1) * 68 + 32 * (lane & 1));
    if (p.f8) {
#pragma unroll
        for (int q = 0; q < 2; ++q) { const pg8::u32x2 lo = pg8::pack8_fp8(row[4 * q] * pg8::W8_SCALE, row[4 * q + 1] * pg8::W8_SCALE), hi = pg8::pack8_fp8(row[4 * q + 2] * pg8::W8_SCALE, row[4 * q + 3] * pg8::W8_SCALE);
            v4u o; o.x = lo.x; o.y = lo.y; o.z = hi.x; o.w = hi.y; *(GAS v4u*)((unsigned char*)p.dst + 16 * q) = o; }
    } else {
#pragma unroll
    for (int q = 0; q < 4; ++q) { const f32x4 a = row[2 * q], b = row[2 * q + 1];
        v4u o; o.x = cvt_pk_bf16(a[0], a[1]); o.y = cvt_pk_bf16(a[2], a[3]); o.z = cvt_pk_bf16(b[0], b[1]); o.w = cvt_pk_bf16(b[2], b[3]);
        *(GAS v4u*)(p.dst + 8 * q) = o; }
    }
    LDS_WAIT(); asm volatile("" ::: "memory");
}
__device__ __forceinline__ void p0_convert_range(Frame& F, int first, int last, int start, int stride) {
    LAS float* T = (LAS float*)(F.lds + F.wave * 16384);
    int it = first + start; P0Item cur; f32x4 va[8]; float ga[8];
    if (it < last) { cur = p0_decode(F, it, F.lane); p0_load(cur, va, ga); }
#pragma unroll 1
    while (it < last) {
        const int nit = it + stride; P0Item nxt = cur; f32x4 vb[8]; float gb[8];
        if (nit < last) { nxt = p0_decode(F, nit, F.lane); p0_load(nxt, vb, gb); }
        p0_store(cur, va, ga, T, F.lane);
        if (nit < last) {
#pragma unroll
            for (int i = 0; i < 8; ++i) { va[i] = vb[i]; ga[i] = gb[i]; } }
        cur = nxt; it = nit;
    }
}
constexpr int FILL_CHUNK = 16, FILL_NCHUNK = P0_I_PAIR / FILL_CHUNK;
static_assert(P0_I_PAIR % FILL_CHUNK == 0, "filler chunks");
__device__ __forceinline__ void fill_convert(Frame& F, int nmax) {
#if FILL_TAILS
#pragma unroll 1
    for (int c = 0; c < nmax; ++c) {
        if (F.tid == 0) F.MISC[16] = __hip_atomic_fetch_add((unsigned*)(F.ctl + CW_FILL), 1u, __ATOMIC_RELAXED, __HIP_MEMORY_SCOPE_AGENT);
        __syncthreads();
        const unsigned ch = F.MISC[16];
        __syncthreads();
        if (ch >= (unsigned)FILL_NCHUNK) break;
        p0_convert_range(F, P0_I_PAIR + (int)ch * FILL_CHUNK, P0_I_PAIR + (int)ch * FILL_CHUNK + FILL_CHUNK, F.wave, NWAVES);
    }
#endif
}
__device__ __forceinline__ bool fill_idle(int nwg, int G, int c) { const int mine = (nwg > c) ? (nwg - c + G - 1) / G : 0; return mine < (nwg + G - 1) / G; }
__device__ __forceinline__ void p0_prologue(Frame& F) {
    const int gw = F.vcu * NWAVES + F.wave, NGW = F.G * NWAVES;
    p0_convert_range(F, 0, FILL_TAILS ? P0_I_PAIR : P0_NITEMS, gw, NGW);
    { bf16* xb = (bf16*)(F.ws + WS_XB); float* ssq0 = ssq_arr(F, 0);
      for (int m = gw; m < M; m += NGW) { const GAS f32x4* xr = (const GAS f32x4*)(F.in[0] + (size_t)m * D) + F.lane; f32x4 v[4]; float s = 0.f;
#pragma unroll
          for (int j = 0; j < 4; ++j) { v[j] = xr[64 * j]; s += (v[j].x * v[j].x + v[j].y * v[j].y) + (v[j].z * v[j].z + v[j].w * v[j].w); }
          s = wave_sum(s);
          GAS v2u* o8 = (GAS v2u*)(xb + (size_t)m * D) + F.lane;
#pragma unroll
          for (int j = 0; j < 4; ++j) { v2u w; w.x = cvt_pk_bf16(v[j].x, v[j].y); w.y = cvt_pk_bf16(v[j].z, v[j].w); o8[64 * j] = w; }
          ssq_store_row(ssq0, m, F.lane, s); } }
    { float* Rt = (float*)(F.ws + WS_MISC + MI_RT); bf16* WsB = (bf16*)(F.ws + WS_MISC + MI_WSB);
      const int gt = F.vcu * NWAVES * 64 + F.tid, NGT = F.G * NWAVES * 64;
      for (int i = gt; i < 2 * NE * 1024; i += NGT) { const int lp = i / (NE * 1024), e = (i / 1024) % NE, k = i % 1024; Rt[i] = F.in[19][((size_t)lp * 1024 + k) * NE + e] * F.in[2][(2 * lp + 1) * 1024 + k]; }
      for (int i = gt; i < 2 * 4 * 128 * 128 / 2; i += NGT) { const float a = F.in[4][2 * i], b = F.in[4][2 * i + 1]; ((unsigned*)WsB)[i] = cvt_pk_bf16(a, b); } }
}

constexpr int VN_STRIDE = 520;
__device__ __forceinline__ void mix_unit_a(Frame& F, int lp, int chunk, int hp) {
    const bf16* za = (const bf16*)(F.ws + WS_R1); bf16* mix = (bf16*)(F.ws + WS_R2); const f32x2* lna = (const f32x2*)(F.ws + WS_MISC + MI_LNA);
    const int R0 = chunk * CHUNK, w = F.wave, l = opaque_v(F.lane), tid = 64 * w + l;
    LAS f32x2* stat = (LAS f32x2*)(F.lds + 128 * VN_STRIDE);
    v4u raw[8];
    { const bf16* src = za + (size_t)(R0 + 16 * w + (l >> 5)) * 1024 + 512 + 256 * hp + 8 * (l & 31);
#pragma unroll
      for (int i = 0; i < 8; ++i) raw[i] = *(const GAS v4u*)(src + (size_t)(2 * i) * 1024); }
    const int h = 2 * hp + (w >> 2), tq = w & 3, li = l & 15, g = l >> 4;
    v2u aup[8][2];
#pragma unroll
    for (int nt = 0; nt < 8; ++nt)
#pragma unroll
        for (int mt = 0; mt < 2; ++mt) aup[nt][mt] = *(const GAS v2u*)(za + (size_t)(R0 + 32 * tq + 16 * mt + li) * 1024 + 128 * h + 16 * nt + 4 * g);
    if (tid < 128) { float s = 0.f, q = 0.f;
#pragma unroll
        for (int p = 0; p < 8; ++p) { const f32x2 v = lna[(size_t)p * M + R0 + tid]; s += v.x; q += v.y; }
        const float mean = s * (1.0f / AW), var = fmaxf(q * (1.0f / AW) - mean * mean, 0.f); stat[tid] = (f32x2){mean, __builtin_amdgcn_rsqf(var + LN_EPS)}; }
    const int c0 = 256 * hp + 8 * (l & 31);
    const f32x4 g0 = *(const GAS f32x4*)(F.in[6] + lp * AW + c0), g1 = *(const GAS f32x4*)(F.in[6] + lp * AW + c0 + 4);
    const f32x4 b0 = *(const GAS f32x4*)(F.in[7] + lp * AW + c0), b1 = *(const GAS f32x4*)(F.in[7] + lp * AW + c0 + 4);
    __syncthreads();
#pragma unroll
    for (int i = 0; i < 8; ++i) { const int row = 16 * w + (l >> 5) + 2 * i; const f32x2 st = stat[row];
        f32x4 v0, v1; v0[0] = bf_lo(raw[i].x); v0[1] = bf_hi(raw[i].x); v0[2] = bf_lo(raw[i].y); v0[3] = bf_hi(raw[i].y); v1[0] = bf_lo(raw[i].z); v1[1] = bf_hi(raw[i].z); v1[2] = bf_lo(raw[i].w); v1[3] = bf_hi(raw[i].w);
        v0 = (v0 - st.x) * st.y * g0 + b0; v1 = (v1 - st.x) * st.y * g1 + b1;
        LAS v2u* dst = (LAS v2u*)(F.lds + row * VN_STRIDE + 16 * (l & 31));
        v2u p0, p1; p0.x = cvt_pk_bf16(v0[0], v0[1]); p0.y = cvt_pk_bf16(v0[2], v0[3]); p1.x = cvt_pk_bf16(v1[0], v1[1]); p1.y = cvt_pk_bf16(v1[2], v1[3]);
        dst[0] = p0; dst[1] = p1; }
    __syncthreads();
    {
        const bf16* WsB = (const bf16*)(F.ws + WS_MISC + MI_WSB) + (size_t)(lp * 4 + h) * 128 * 128;
        bf16x8 Y[2][4];
#pragma unroll
        for (int mt = 0; mt < 2; ++mt)
#pragma unroll
            for (int kk = 0; kk < 4; ++kk) Y[mt][kk] = *(const GAS bf16x8*)(WsB + (size_t)(32 * tq + 16 * mt + li) * 128 + 32 * kk + 8 * g);
        const float* bs = F.in[5] + (lp * 4 + h) * 128;
#pragma unroll
        for (int nt = 0; nt < 8; ++nt) {
            f32x4 acc[2];
#pragma unroll
            for (int mt = 0; mt < 2; ++mt) acc[mt] = (f32x4){0.f, 0.f, 0.f, 0.f};
#pragma unroll
            for (int kk = 0; kk < 4; ++kk) {
                const LAS unsigned short* xp = (const LAS unsigned short*)(F.lds + (32 * kk + 8 * g) * VN_STRIDE + 2 * (128 * (w >> 2) + 16 * nt + li));
                bf16x8 X;
#pragma unroll
                for (int j = 0; j < 8; ++j) X[j] = (short)xp[j * (VN_STRIDE / 2)];
#pragma unroll
                for (int mt = 0; mt < 2; ++mt) acc[mt] = __builtin_amdgcn_mfma_f32_16x16x32_bf16(X, Y[mt][kk], acc[mt], 0, 0, 0);
            }
#pragma unroll
            for (int mt = 0; mt < 2; ++mt) { const int t = 32 * tq + 16 * mt + li, d0 = 16 * nt + 4 * g; const float bias = bs[t];
                const size_t off = (size_t)(R0 + t) * 1024 + 128 * h + d0;
                const v2u au = aup[nt][mt];
                v2u o; o.x = cvt_pk_bf16(bf_lo(au.x) * (acc[mt][0] + bias), bf_hi(au.x) * (acc[mt][1] + bias)); o.y = cvt_pk_bf16(bf_lo(au.y) * (acc[mt][2] + bias), bf_hi(au.y) * (acc[mt][3] + bias));
                *(GAS v2u*)(mix + off) = o; }
        }
    }
    __syncthreads();
}
__device__ __forceinline__ void mix_unit_b(Frame& F, int lp, int hc) {
    const bf16* glu = (const bf16*)(F.ws + WS_R1 + 32 * MiB); bf16* mix = (bf16*)(F.ws + WS_R2);
    const int R0 = hc * 64, p0 = R0 % SEQ, tid = opaque_v(F.tid), lane = tid & 63;
    for (int idx = tid; idx < 94 * 64; idx += NWAVES * 64) { const int r = idx >> 6, c16 = idx & 63, pos = p0 - 15 + r;
        v4u v = (v4u){0u, 0u, 0u, 0u}; if (pos >= 0 && pos < SEQ) v = *(const GAS v4u*)(glu + (size_t)(R0 - 15 + r) * BW + 8 * c16);
        *(LAS v4u*)(F.lds + r * 1024 + 16 * c16) = v; }
    const int cp = tid & 255, grp = tid >> 8, wg4 = F.wave & 3;
    f32x2 wt[KB];
#pragma unroll
    for (int j = 0; j < KB; ++j) wt[j] = *(const GAS f32x2*)(F.in[8] + ((size_t)lp * KB + j) * BW + 2 * cp);
    const f32x2 cb = *(const GAS f32x2*)(F.in[9] + lp * BW + 2 * cp), lg = *(const GAS f32x2*)(F.in[10] + lp * BW + 2 * cp), lb = *(const GAS f32x2*)(F.in[11] + lp * BW + 2 * cp);
    LAS float* red = (LAS float*)(F.lds + 98304);
    LAS float* st = (LAS float*)(F.lds + 98304 + 1024);
    __syncthreads();
#pragma unroll 1
    for (int run = 0; run < 2; ++run) {
        const int o0 = 32 * grp + 16 * run;
        f32x2 acc[16];
#pragma unroll
        for (int o = 0; o < 16; ++o) acc[o] = cb;
        unsigned xw = *(const LAS unsigned*)(F.lds + o0 * 1024 + 4 * cp);
#pragma unroll
        for (int r = 0; r < 46; ++r) { unsigned xnx = 0u; if (r + 1 < 46) xnx = *(const LAS unsigned*)(F.lds + (o0 + r + 1) * 1024 + 4 * cp);
            const f32x2 x = (f32x2){bf_lo(xw), bf_hi(xw)};
#pragma unroll
            for (int o = 0; o < 16; ++o) { if (r - o >= 0 && r - o < KB) acc[o] = __builtin_elementwise_fma(wt[r - o], x, acc[o]); }
            __builtin_amdgcn_sched_barrier(0); xw = xnx; }
#pragma unroll
        for (int o = 0; o < 16; ++o) { const float s = wave_sum(acc[o].x + acc[o].y), q = wave_sum(acc[o].x * acc[o].x + acc[o].y * acc[o].y);
            if (lane == 0) { red[((grp * 4 + wg4) * 16 + o) * 2] = s; red[((grp * 4 + wg4) * 16 + o) * 2 + 1] = q; } }
        __syncthreads();
        if (tid < 32) { const int gg = tid >> 4, o = tid & 15; float s = 0.f, q = 0.f;
#pragma unroll
            for (int k = 0; k < 4; ++k) { s += red[((gg * 4 + k) * 16 + o) * 2]; q += red[((gg * 4 + k) * 16 + o) * 2 + 1]; }
            const float mean = s * (1.0f / BW), var = fmaxf(q * (1.0f / BW) - mean * mean, 0.f);
            st[(gg * 16 + o) * 2] = mean; st[(gg * 16 + o) * 2 + 1] = __builtin_amdgcn_rsqf(var + LN_EPS); }
        __syncthreads();
#pragma unroll
        for (int o = 0; o < 16; ++o) { const float mean = st[(grp * 16 + o) * 2], rstd = st[(grp * 16 + o) * 2 + 1];
            const float y0 = (acc[o].x - mean) * rstd * lg.x + lb.x, y1 = (acc[o].y - mean) * rstd * lg.y + lb.y;
            *(GAS unsigned*)(mix + (size_t)(R0 + o0 + o) * 1024 + 512 + 2 * cp) = cvt_pk_bf16(siluf_fast(y0), siluf_fast(y1)); }
    }
    __syncthreads();
}

__device__ __forceinline__ void conv3_phase(Frame& F, int lp) {
    const bf16* gb = (const bf16*)(F.ws + WS_R1); const bf16* cv = (const bf16*)(F.ws + WS_R1 + 32 * MiB); bf16* y = (bf16*)(F.ws + WS_R2);
    const int gw = F.vcu * NWAVES + F.wave, NGW = F.G * NWAVES;
    for (int item = gw; item < 2 * (M / 16); item += NGW) {
        const int r0 = (item >> 1) * 16, ch0 = 512 * (item & 1) + 8 * F.lane, p = r0 % SEQ;
        f32x4 w[3][2];
#pragma unroll
        for (int j = 0; j < 3; ++j) { w[j][0] = *(const GAS f32x4*)(F.in[14] + ((size_t)lp * 3 + j) * 1024 + ch0); w[j][1] = *(const GAS f32x4*)(F.in[14] + ((size_t)lp * 3 + j) * 1024 + ch0 + 4); }
        v4u prev = (v4u){0u, 0u, 0u, 0u}; if (p > 0) prev = *(const GAS v4u*)(cv + (size_t)(r0 - 1) * 1024 + ch0);
        v4u cur = *(const GAS v4u*)(cv + (size_t)r0 * 1024 + ch0);
#pragma unroll 4
        for (int i = 0; i < 16; ++i) { const int row = r0 + i;
            v4u nxt = (v4u){0u, 0u, 0u, 0u}; if (p + i + 1 < SEQ) nxt = *(const GAS v4u*)(cv + (size_t)(row + 1) * 1024 + ch0);
            const v4u g = *(const GAS v4u*)(gb + (size_t)row * 1024 + ch0);
            v4u o;
#pragma unroll
            for (int k = 0; k < 4; ++k) { const int a = (2 * k) & 3, b = (2 * k + 1) & 3, hh = k >> 1;
                const float c0 = w[0][hh][a] * bf_lo(prev[k]) + w[1][hh][a] * bf_lo(cur[k]) + w[2][hh][a] * bf_lo(nxt[k]);
                const float c1 = w[0][hh][b] * bf_hi(prev[k]) + w[1][hh][b] * bf_hi(cur[k]) + w[2][hh][b] * bf_hi(nxt[k]);
                o[k] = cvt_pk_bf16(bf_lo(g[k]) * c0, bf_hi(g[k]) * c1); }
            *(GAS v4u*)(y + (size_t)row * 1024 + ch0) = o; prev = cur; cur = nxt; }
    }
}

template <int N> __device__ __forceinline__ void reduce_scatter_step(float (&v)[64], int lane, int off) {
#pragma unroll
    for (int i = 0; i < N / 2; ++i) { const bool hi = (lane & off) != 0; const float keep = hi ? v[i + N / 2] : v[i], send = hi ? v[i] : v[i + N / 2]; v[i] = keep + __shfl_xor(send, off); }
}
__device__ __forceinline__ void router_phase(Frame& F, int lp, const float* ssq) {
    const bf16* xb = (const bf16*)(F.ws + WS_XB); const float* Rt = (const float*)(F.ws + WS_MISC + MI_RT) + (size_t)lp * NE * 1024;
    int* tok_e = (int*)(F.ws + WS_MISC + MI_TOKE); float* tok_g = (float*)(F.ws + WS_MISC + MI_TOKG); int* tok_r = (int*)(F.ws + WS_MISC + MI_TOKR); int* cnt = (int*)(F.ws + WS_MISC + MI_CNT); float* tok_rs = (float*)(F.ws + WS_MISC + MI_TOKRS);
    LAS int* te = (LAS int*)(F.lds);
    LAS float* lgs = (LAS float*)(F.lds + 1024) + F.wave * 64;
    const int l = F.lane;
    for (int vb = opaque_s((int)blockIdx.x); vb < M / 64; vb += F.G) {
        const int t0 = 64 * vb + 8 * F.wave;
        v4u xa[8], xc[8];
#pragma unroll
        for (int j = 0; j < 8; ++j) { xa[j] = *(const GAS v4u*)(xb + (size_t)(t0 + j) * 1024 + 8 * l); xc[j] = *(const GAS v4u*)(xb + (size_t)(t0 + j) * 1024 + 512 + 8 * l); }
        float sA = (l < 32) ? ssq[(size_t)(l & 3) * M + t0 + (l >> 2)] : 0.f;
        float v[64];
#pragma unroll
        for (int e = 0; e < NE; ++e) { const f32x4 r0 = *(const GAS f32x4*)(Rt + e * 1024 + 8 * l), r1 = *(const GAS f32x4*)(Rt + e * 1024 + 8 * l + 4), r2 = *(const GAS f32x4*)(Rt + e * 1024 + 512 + 8 * l), r3 = *(const GAS f32x4*)(Rt + e * 1024 + 512 + 8 * l + 4);
#pragma unroll
            for (int j = 0; j < 8; ++j) { const v4u a = xa[j], b = xc[j];
                f32x4 s = (f32x4){bf_lo(a.x), bf_hi(a.x), bf_lo(a.y), bf_hi(a.y)} * r0; s = s + (f32x4){bf_lo(a.z), bf_hi(a.z), bf_lo(a.w), bf_hi(a.w)} * r1;
                s = s + (f32x4){bf_lo(b.x), bf_hi(b.x), bf_lo(b.y), bf_hi(b.y)} * r2; s = s + (f32x4){bf_lo(b.z), bf_hi(b.z), bf_lo(b.w), bf_hi(b.w)} * r3;
                v[j * 8 + e] = (s[0] + s[1]) + (s[2] + s[3]); } }
        reduce_scatter_step<64>(v, l, 32); reduce_scatter_step<32>(v, l, 16); reduce_scatter_step<16>(v, l, 8); reduce_scatter_step<8>(v, l, 4); reduce_scatter_step<4>(v, l, 2); reduce_scatter_step<2>(v, l, 1);
        lgs[l] = v[0];
        sA += __shfl_xor(sA, 1); sA += __shfl_xor(sA, 2);
        const int jt = l & 7;
        const float rs = __builtin_amdgcn_rsqf(__shfl(sA, 4 * jt) * (1.0f / 1024.0f) + RMS_EPS);
        LDS_WAIT(); asm volatile("" ::: "memory");
        if (l < 8) { float lg[NE];
#pragma unroll
            for (int e = 0; e < NE; ++e) lg[e] = lgs[l * 8 + e];
            int i0 = 0; float v0 = lg[0];
#pragma unroll
            for (int e = 1; e < NE; ++e) if (lg[e] > v0) { v0 = lg[e]; i0 = e; }
            int i1 = -1; float v1 = -3.0e38f;
#pragma unroll
            for (int e = 0; e < NE; ++e) if (e != i0 && lg[e] > v1) { v1 = lg[e]; i1 = e; }
            const float g0 = __builtin_amdgcn_rcpf(1.0f + __expf((v1 - v0) * rs)), g1 = 1.0f - g0;
            const int tl = 8 * F.wave + l, t = t0 + l;
            te[2 * tl] = i0; te[2 * tl + 1] = i1; tok_e[2 * t] = i0; tok_e[2 * t + 1] = i1; tok_g[2 * t] = g0; tok_g[2 * t + 1] = g1; tok_rs[t] = rs; }
        __syncthreads();
        if (F.wave == 0) { const int e0 = te[2 * l], e1 = te[2 * l + 1]; int r0 = 0, r1 = 0, mycnt = 0;
#pragma unroll
            for (int e = 0; e < NE; ++e) { const unsigned long long mk = __ballot(e0 == e || e1 == e); const int rk = __popcll(mk & ((1ull << l) - 1ull)), c = __popcll(mk);
                if (e0 == e) r0 = rk; if (e1 == e) r1 = rk; if (l == e) mycnt = c; }
            const int t = 64 * vb + l; tok_r[2 * t] = r0; tok_r[2 * t + 1] = r1; if (l < NE) cnt[vb * NE + l] = mycnt; }
        __syncthreads();
    }
}
__device__ __forceinline__ void gather_phase(Frame& F) {
    const bf16* xb = (const bf16*)(F.ws + WS_XB); bf16* xg = (bf16*)(F.ws + WS_R1);
    const int* tok_e = (const int*)(F.ws + WS_MISC + MI_TOKE); const float* tok_g = (const float*)(F.ws + WS_MISC + MI_TOKG); const int* tok_r = (const int*)(F.ws + WS_MISC + MI_TOKR);
    int* tok_s = (int*)(F.ws + WS_MISC + MI_TOKS); const int* cnt = (const int*)(F.ws + WS_MISC + MI_CNT); unsigned* hdr = (unsigned*)(F.ws + WS_MISC + MI_HDR);
    const float* tok_rs = (const float*)(F.ws + WS_MISC + MI_TOKRS); float* rsg = (float*)(F.ws + WS_MISC + MI_RSG); float* gtg = (float*)(F.ws + WS_MISC + MI_GTG);
    LAS int* part = (LAS int*)(F.lds);
    LAS int* fin = (LAS int*)(F.lds + 256);
    const int l = F.lane;
    for (int vb = opaque_s((int)blockIdx.x); vb < M / 64; vb += F.G) {
        if (F.tid < 256) { int c[16];
            const v4u c0 = *(const GAS v4u*)(cnt + F.tid * NE), c1 = *(const GAS v4u*)(cnt + F.tid * NE + 4);
            c[0] = (int)c0.x; c[1] = (int)c0.y; c[2] = (int)c0.z; c[3] = (int)c0.w; c[4] = (int)c1.x; c[5] = (int)c1.y; c[6] = (int)c1.z; c[7] = (int)c1.w;
#pragma unroll
            for (int e = 0; e < NE; ++e) c[8 + e] = (F.tid < vb) ? c[e] : 0;
#pragma unroll
            for (int st = 0; st < 4; ++st) { const int off = 32 >> st, n = 16 >> st;
#pragma unroll
                for (int i = 0; i < 8; ++i) if (i < n / 2) { const bool hi = (l & off) != 0; const int keep = hi ? c[i + n / 2] : c[i], send = hi ? c[i] : c[i + n / 2]; c[i] = keep + __shfl_xor(send, off); } }
            int tot = c[0]; tot += __shfl_xor(tot, 2); tot += __shfl_xor(tot, 1);
            if ((l & 3) == 0) part[F.wave * 16 + (l >> 2)] = tot; }
        __syncthreads();
        if (F.tid == 0) { int off = 0;
            for (int e = 0; e < NE; ++e) { const int tot = part[e] + part[16 + e] + part[32 + e] + part[48 + e], bas = part[8 + e] + part[24 + e] + part[40 + e] + part[56 + e];
                const int pc = (tot + 255) & ~255; fin[e] = off + bas; fin[8 + e] = pc; off += pc; } }
        __syncthreads();
        if (vb == 0 && F.tid == 0) { unsigned p = 0; for (int e = 0; e < NE; ++e) { const int np_e = fin[8 + e] >> 8; for (int i = 0; i < np_e; ++i) hdr[1 + p++] = (unsigned)e; } hdr[0] = p; }
        int slot = 0;
        { const int pr = 16 * F.wave + (l & 15), t = 64 * vb + (pr >> 1), k = pr & 1; const int e = tok_e[2 * t + k]; slot = fin[e] + tok_r[2 * t + k];
          if (l < 16) { rsg[slot] = tok_rs[t]; gtg[slot] = tok_g[2 * t + k]; tok_s[2 * t + k] = slot; } }
#pragma unroll
        for (int bt = 0; bt < 2; ++bt) {
#if MOE_FP8
            v4u ra[8], rb[8];
#pragma unroll
            for (int j = 0; j < 8; ++j) { const int t = 64 * vb + ((16 * F.wave + 8 * bt + j) >> 1); ra[j] = *(const GAS v4u*)(xb + (size_t)t * 1024 + 16 * l); rb[j] = *(const GAS v4u*)(xb + (size_t)t * 1024 + 16 * l + 8); }
#pragma unroll
            for (int j = 0; j < 8; ++j) { const int sl = __builtin_amdgcn_readlane(slot, 8 * bt + j); const v4u a = ra[j], b = rb[j];
                const pg8::u32x2 lo = pg8::pack8_fp8((f32x4){bf_lo(a.x), bf_hi(a.x), bf_lo(a.y), bf_hi(a.y)}, (f32x4){bf_lo(a.z), bf_hi(a.z), bf_lo(a.w), bf_hi(a.w)});
                const pg8::u32x2 hi = pg8::pack8_fp8((f32x4){bf_lo(b.x), bf_hi(b.x), bf_lo(b.y), bf_hi(b.y)}, (f32x4){bf_lo(b.z), bf_hi(b.z), bf_lo(b.w), bf_hi(b.w)});
                v4u o; o.x = lo.x; o.y = lo.y; o.z = hi.x; o.w = hi.y; *(GAS v4u*)((unsigned char*)xg + (size_t)sl * 1024 + 16 * l) = o; }
#else
            v4u ra[8], rb[8];
#pragma unroll
            for (int j = 0; j < 8; ++j) { const int t = 64 * vb + ((16 * F.wave + 8 * bt + j) >> 1); ra[j] = *(const GAS v4u*)(xb + (size_t)t * 1024 + 8 * l); rb[j] = *(const GAS v4u*)(xb + (size_t)t * 1024 + 512 + 8 * l); }
#pragma unroll
            for (int j = 0; j < 8; ++j) { const int sl = __builtin_amdgcn_readlane(slot, 8 * bt + j); *(GAS v4u*)(xg + (size_t)sl * 1024 + 8 * l) = ra[j]; *(GAS v4u*)(xg + (size_t)sl * 1024 + 512 + 8 * l) = rb[j]; }
#endif
        }
        __syncthreads();
    }
}
__device__ __forceinline__ void combine_phase(Frame& F, float* ssq_next, bool last) {
    bf16* xb = (bf16*)(F.ws + WS_XB); const bf16* og = (const bf16*)(F.ws + WS_R2); const int* tok_s = (const int*)(F.ws + WS_MISC + MI_TOKS);
    const int gw = F.vcu * NWAVES + F.wave, NGW = F.G * NWAVES, l = F.lane;
    for (int tb = 2 * gw; tb < M; tb += 2 * NGW) {
        const int sl = (l < 4) ? tok_s[2 * tb + l] : 0;
        int s[4];
#pragma unroll
        for (int i = 0; i < 4; ++i) s[i] = __builtin_amdgcn_readlane(sl, i);
        v4u xr[2][2], ar[2][2], br[2][2];
#pragma unroll
        for (int q = 0; q < 2; ++q)
#pragma unroll
            for (int hh = 0; hh < 2; ++hh) { const int c0 = 512 * hh + 8 * l; xr[q][hh] = *(const GAS v4u*)(xb + (size_t)(tb + q) * 1024 + c0); ar[q][hh] = *(const GAS v4u*)(og + (size_t)s[2 * q] * 1024 + c0); br[q][hh] = *(const GAS v4u*)(og + (size_t)s[2 * q + 1] * 1024 + c0); }
#pragma unroll
        for (int q = 0; q < 2; ++q) { const int t = tb + q;
            float xn[16]; float ss = 0.f;
#pragma unroll
            for (int hh = 0; hh < 2; ++hh) { const v4u x = xr[q][hh], a = ar[q][hh], b = br[q][hh];
#pragma unroll
                for (int k = 0; k < 4; ++k) { xn[8 * hh + 2 * k] = bf_lo(x[k]) + bf_lo(a[k]) + bf_lo(b[k]); xn[8 * hh + 2 * k + 1] = bf_hi(x[k]) + bf_hi(a[k]) + bf_hi(b[k]); } }
#pragma unroll
            for (int i = 0; i < 16; ++i) ss += xn[i] * xn[i];
            ss = wave_sum(ss);
            if (!last) {
#pragma unroll
                for (int hh = 0; hh < 2; ++hh) { v4u o;
#pragma unroll
                    for (int k = 0; k < 4; ++k) o[k] = cvt_pk_bf16(xn[8 * hh + 2 * k], xn[8 * hh + 2 * k + 1]);
                    *(GAS v4u*)(xb + (size_t)t * 1024 + 512 * hh + 8 * l) = o; }
                ssq_store_row(ssq_next, t, l, ss);
            } else { const float r = __builtin_amdgcn_rsqf(ss * (1.0f / 1024.0f) + RMS_EPS);
#pragma unroll
                for (int hh = 0; hh < 2; ++hh) { const int c0 = 512 * hh + 8 * l; const f32x4 g0 = *(const GAS f32x4*)(F.in[23] + c0), g1 = *(const GAS f32x4*)(F.in[23] + c0 + 4);
                    f32x4 o0, o1;
#pragma unroll
                    for (int k = 0; k < 4; ++k) { o0[k] = xn[8 * hh + k] * r * g0[k]; o1[k] = xn[8 * hh + 4 + k] * r * g1[k]; }
                    *(GAS f32x4*)(F.out + (size_t)t * 1024 + c0) = o0; *(GAS f32x4*)(F.out + (size_t)t * 1024 + c0 + 4) = o1; }
            }
        }
    }
}
__device__ __forceinline__ void finalize_phase(Frame& F) {
    const bf16* xb = (const bf16*)(F.ws + WS_XB);
    const int gw = F.vcu * NWAVES + F.wave, NGW = F.G * NWAVES, l = F.lane;
    for (int t = gw; t < M; t += NGW) {
        float xn[16]; float ss = 0.f;
#pragma unroll
        for (int hh = 0; hh < 2; ++hh) { const v4u x = *(const GAS v4u*)(xb + (size_t)t * 1024 + 512 * hh + 8 * l);
#pragma unroll
            for (int k = 0; k < 4; ++k) { xn[8 * hh + 2 * k] = bf_lo(x[k]); xn[8 * hh + 2 * k + 1] = bf_hi(x[k]); } }
#pragma unroll
        for (int i = 0; i < 16; ++i) ss += xn[i] * xn[i];
        ss = wave_sum(ss); const float r = __builtin_amdgcn_rsqf(ss * (1.0f / 1024.0f) + RMS_EPS);
#pragma unroll
        for (int hh = 0; hh < 2; ++hh) { const int c0 = 512 * hh + 8 * l; const f32x4 g0 = *(const GAS f32x4*)(F.in[23] + c0), g1 = *(const GAS f32x4*)(F.in[23] + c0 + 4);
            f32x4 o0, o1;
#pragma unroll
            for (int k = 0; k < 4; ++k) { o0[k] = xn[8 * hh + k] * r * g0[k]; o1[k] = xn[8 * hh + 4 + k] * r * g1[k]; }
            *(GAS f32x4*)(F.out + (size_t)t * 1024 + c0) = o0; *(GAS f32x4*)(F.out + (size_t)t * 1024 + c0 + 4) = o1; }
    }
}

#if MK_PER_PHASE
struct BarT { int unused; };
#define GRID_BAR() do { } while (0)
#else
typedef XcdBarrier BarT;
#define GRID_BAR() xcd_barrier(bar_)
#endif
#ifndef PH_ENABLE
#define PH_ENABLE 0x3fff
#endif
#define PH_ON(j) (((PH_ENABLE) >> (j)) & 1)
#ifndef DUP_MASK
#define DUP_MASK 0
#endif
#define NREP(j) ((((DUP_MASK) >> (j)) & 1) ? 2 : 1)
#define IN(k) (lo <= (k) && (k) < hi && (k) <= MK_LAST_PHASE)
#ifdef BAR_TWICE
#define SEAM(k) do { if (IN(k) && (k) + 1 < hi) { GRID_BAR(); GRID_BAR(); } } while (0)
#else
#define SEAM(k) do { if (IN(k) && (k) + 1 < hi) GRID_BAR(); } while (0)
#endif
#define xb ((bf16*)(wsl + WS_XB))
#define r1 ((bf16*)(wsl + WS_R1))
#define r1b ((bf16*)(wsl + WS_R1 + 32 * MiB))
#define r2 ((bf16*)(wsl + WS_R2))
#define r3 ((bf16*)(wsl + WS_R3))
#define SQ(s) ((float*)(wsl + WS_SSQ) + (size_t)(s) * 4 * M)
#define LOCALF() Frame Fl = F; Fl.tid = opaque_v(F.tid); Fl.lane = Fl.tid & 63; Fl.wave = opaque_s(F.wave); Fl.vcu = opaque_s(F.vcu); Fl.in = opaque_tab(F.in); Fl.ws = wsl; const int bx = opaque_s(bx0); (void)bx
#define PH_BEGIN(j, id) if (PH_ON(j) && IN(id)) { _Pragma("unroll 1") for (int rep_ = 0; rep_ < NREP(j); ++rep_) { if (rep_) GRID_BAR(); GAS unsigned char* wsl = F.ws; asm volatile("" : "+s"(wsl));
#define PH_END(id) } } SEAM(id);
template <int lp> __device__ __forceinline__ void pair_body(Frame& F, const BarT& bar_, const int lo, const int hi, const int bx0) {
        const int pb = 1 + 13 * lp;
        PH_BEGIN(0, pb + 0) const int bx = opaque_s(bx0); pg8::Gemm g{xb, ev_wl(wsl, lp, EVO_WIN), M, EV_IN, D}; pg8::StaticOrder S; S.init(M, EV_IN, F.G, bx, WGM_E1);
            pg8::EpiEvenIn E{r1, r1b, SQ(4 * lp), (pg8::f32x2*)(wsl + WS_MISC + MI_LNA)}; pg8::gemm_phase<pg8::EpiEvenIn, pg8::StaticOrder, EPI_ALIGN_HEAVY, true>(F.lds, g, S, E); PH_END(pb + 0)
        PH_BEGIN(1, pb + 1) LOCALF(); for (int u = bx; u < 256; u += F.G) { _Pragma("unroll 1") for (int ra = 0; ra < NREP(14); ++ra) mix_unit_a(Fl, lp, u >> 1, u & 1); _Pragma("unroll 1") for (int rb = 0; rb < NREP(15); ++rb) mix_unit_b(Fl, lp, u); } PH_END(pb + 1)
        PH_BEGIN(2, pb + 2) const int bx = opaque_s(bx0); pg8::Gemm g{r2, ev_wl(wsl, lp, EVO_WOUT), M, D, D}; pg8::StaticOrder S; S.init(M, D, F.G, bx, WGM_N4);
            constexpr bool X8 = (FFN2_FP8 && lp == 1); pg8::EpiRes<X8> E{xb, SQ(4 * lp + 1), 1.0f, (unsigned char*)r1, (LAS float*)(F.lds + RED_OFF)}; pg8::gemm_phase<pg8::EpiRes<X8>, pg8::StaticOrder, true, true>(F.lds, g, S, E); PH_END(pb + 2)
        PH_BEGIN(3, pb + 3) const int bx = opaque_s(bx0); constexpr bool F8 = (FFN2_FP8 && lp == 1); pg8::Gemm g{F8 ? r1 : xb, ev_wl(wsl, lp, EVO_W13), M, NFF2, D}; pg8::StaticOrder S; S.init(M, NFF2, F.G, bx, WGM_E4);
            pg8::EpiGlu<false, F8> E{r3, DFF, SQ(4 * lp + 1), F8 ? pg8::W8_INV : 1.0f}; pg8::gemm_phase<pg8::EpiGlu<false, F8>, pg8::StaticOrder, EPI_ALIGN_HEAVY, true, F8>(F.lds, g, S, E);
            if constexpr (lp == 0) { if (fill_idle(S.nwg, F.G, bx)) { LOCALF(); fill_convert(Fl, 5); } } PH_END(pb + 3)
        PH_BEGIN(4, pb + 4) const int bx = opaque_s(bx0); pg8::Gemm g{r3, ev_wl(wsl, lp, EVO_W2), M, D, DFF}; pg8::StaticOrder S; S.init(M, D, F.G, bx, WGM_N4);
            constexpr bool F8 = (FFN2_FP8 && lp == 1); pg8::EpiRes<false> E{xb, SQ(4 * lp + 2), F8 ? pg8::W8_INV : 1.0f, nullptr, (LAS float*)(F.lds + RED_OFF)}; pg8::gemm_phase<pg8::EpiRes<false>, pg8::StaticOrder, true, true, F8>(F.lds, g, S, E); PH_END(pb + 4)
        PH_BEGIN(5, pb + 5) const int bx = opaque_s(bx0); pg8::Gemm g{xb, od_wl(wsl, lp, ODO_WIN), M, OD_IN, D}; pg8::StaticOrder S; S.init(M, OD_IN, F.G, bx, WGM_O1);
            pg8::EpiOddIn E{r1, r1b, SQ(4 * lp + 2)}; pg8::gemm_phase<pg8::EpiOddIn, pg8::StaticOrder, EPI_ALIGN_HEAVY, true>(F.lds, g, S, E); PH_END(pb + 5)
        PH_BEGIN(6, pb + 6) LOCALF(); conv3_phase(Fl, lp); PH_END(pb + 6)
        PH_BEGIN(7, pb + 7) const int bx = opaque_s(bx0); pg8::Gemm g{r2, od_wl(wsl, lp, ODO_WOUT), M, D, D}; pg8::StaticOrder S; S.init(M, D, F.G, bx, WGM_N4);
            pg8::EpiRes<false> E{xb, SQ(4 * lp + 3), 1.0f, nullptr, (LAS float*)(F.lds + RED_OFF)}; pg8::gemm_phase<pg8::EpiRes<false>, pg8::StaticOrder, true, true>(F.lds, g, S, E); PH_END(pb + 7)
        PH_BEGIN(8, pb + 8) LOCALF(); router_phase(Fl, lp, SQ(4 * lp + 3)); PH_END(pb + 8)
        PH_BEGIN(9, pb + 9) LOCALF(); gather_phase(Fl); PH_END(pb + 9)
        PH_BEGIN(10, pb + 10) const int bx = opaque_s(bx0); const unsigned* hdr = (const unsigned*)(wsl + WS_MISC + MI_HDR);
            int np = __builtin_amdgcn_readfirstlane((int)__hip_atomic_load(hdr, RLX_AGENT)); np = np > MAXP ? MAXP : np;
            { LAS unsigned* ptab = (LAS unsigned*)(F.lds + PTAB_OFF); const int tid_ = opaque_v(F.tid); if (tid_ < MAXP) ptab[tid_] = (tid_ < np) ? __hip_atomic_load(hdr + 1 + tid_, RLX_AGENT) : 0u; __syncthreads(); }
            pg8::Gemm g{r1, od_wl(wsl, lp, ODO_W13), np * 256, NFF2, D}; pg8::MoeOrder S; S.init(np * 256, NFF2, F.G, bx, WGM_O6); S.tab = (const LAS unsigned*)(F.lds + PTAB_OFF); S.estride = (size_t)NFF2 * D * (MOE_FP8 ? 1 : 2);
            pg8::EpiGlu<true, MOE_FP8 != 0> E{r3, DFF, (const float*)(wsl + WS_MISC + MI_RSG), MOE_FP8 ? pg8::W8_INV : 1.0f}; pg8::gemm_phase<pg8::EpiGlu<true, MOE_FP8 != 0>, pg8::MoeOrder, EPI_ALIGN_HEAVY, F8_SP2, MOE_FP8 != 0>(F.lds, g, S, E);
            if constexpr (lp == 0) { if (fill_idle(S.nwg, F.G, bx)) { LOCALF(); fill_convert(Fl, 3); } } PH_END(pb + 10)
        PH_BEGIN(11, pb + 11) const int bx = opaque_s(bx0); const unsigned* hdr = (const unsigned*)(wsl + WS_MISC + MI_HDR);
            int np = __builtin_amdgcn_readfirstlane((int)__hip_atomic_load(hdr, RLX_AGENT)); np = np > MAXP ? MAXP : np;
            { LAS unsigned* ptab = (LAS unsigned*)(F.lds + PTAB_OFF); const int tid_ = opaque_v(F.tid); if (tid_ < MAXP) ptab[tid_] = (tid_ < np) ? __hip_atomic_load(hdr + 1 + tid_, RLX_AGENT) : 0u; __syncthreads(); }
            pg8::Gemm g{r3, od_wl(wsl, lp, ODO_W2), np * 256, D, DFF}; pg8::MoeOrder S; S.init(np * 256, D, F.G, bx, WGM_O7); S.tab = (const LAS unsigned*)(F.lds + PTAB_OFF); S.estride = (size_t)D * DFF * (MOE_FP8 ? 1 : 2);
            pg8::EpiMoeDown E{r2, (const float*)(wsl + WS_MISC + MI_GTG), MOE_FP8 ? pg8::W8_INV : 1.0f}; pg8::gemm_phase<pg8::EpiMoeDown, pg8::MoeOrder, true, F8_SP2, MOE_FP8 != 0>(F.lds, g, S, E);
            if constexpr (lp == 0) { if (fill_idle(S.nwg, F.G, bx)) { LOCALF(); fill_convert(Fl, 6); } } PH_END(pb + 11)
        PH_BEGIN(12, pb + 12) LOCALF(); combine_phase(Fl, SQ((4 * lp + 4) & 7), lp == 1); if constexpr (lp == 0) fill_convert(Fl, 1 << 30); PH_END(pb + 12)
    }


struct Args { const float* in[24]; float* out; unsigned char* ws; int ph_lo, ph_hi; };
__global__ void __launch_bounds__(NWAVES * 64, 2) enc_fwd(Args args) {
    extern __shared__ __attribute__((aligned(16))) unsigned char lds[];
    Frame F;
    F.lds = (LAS unsigned char*)lds;
    F.MISC = (volatile LAS unsigned*)(F.lds + MISC_OFF);
    F.tid = threadIdx.x; F.lane = F.tid & 63; F.wave = __builtin_amdgcn_readfirstlane(F.tid >> 6);
    F.G = gridDim.x; { const int bx = blockIdx.x; F.vcu = (F.G % 8 == 0) ? (bx % 8) * (F.G / 8) + bx / 8 : bx; }
    F.ws = (GAS unsigned char*)args.ws; F.ctl = (gu32*)(args.ws + WS_CTL); F.out = args.out;
    F.in = (intab_t)__builtin_amdgcn_kernarg_segment_ptr();
    for (int u = F.tid; u < 128; u += NWAVES * 64) ((LAS unsigned*)(F.lds + MISC_OFF))[u] = 0u;
    __syncthreads();
#if MK_PER_PHASE
    const BarT bar_{0};
#else
    const BarT bar_ = xcd_barrier_post((unsigned*)(F.ctl + CW_BAR), F.MISC + 8);
#endif
    const int lo = args.ph_lo, hi = args.ph_hi;
    const int bx0 = (int)blockIdx.x;
    PH_BEGIN(13, 0) LOCALF(); p0_prologue(Fl); PH_END(0)

    pair_body<0>(F, bar_, lo, hi, bx0);
    pair_body<1>(F, bar_, lo, hi, bx0);
#if MK_LAST_PHASE < 26
    if (hi == NPHASE + 1) { if (lo < NPHASE) GRID_BAR(); LOCALF(); finalize_phase(Fl); }
#endif
#undef IN
#undef xb
#undef r1
#undef r1b
#undef r2
#undef r3
#undef SQ
#undef SEAM
}

extern "C" void kernel_launch(void* const* d_in, const int* in_sizes, int n_in, void* d_out, int out_size, void* d_ws, size_t ws_size, hipStream_t stream) {
    static int grid = 0;
    if (grid == 0) {
        if (n_in != 24 || in_sizes[0] != M * D || out_size != M * D || ws_size < WS_END) { fprintf(stderr, "kernel_launch: unexpected shapes (n_in %d, in0 %d, out %d, ws %zu < %zu); nothing launched\n", n_in, n_in > 0 ? in_sizes[0] : -1, out_size, ws_size, (size_t)WS_END); grid = -1; return; }
        int dev = 0, cus = 0, per_cu = 0;
        if (hipGetDevice(&dev) != hipSuccess || hipDeviceGetAttribute(&cus, hipDeviceAttributeMultiprocessorCount, dev) != hipSuccess) { grid = -1; return; }
        if (hipFuncSetAttribute((const void*)enc_fwd, hipFuncAttributeMaxDynamicSharedMemorySize, LDS_BYTES) != hipSuccess) { fprintf(stderr, "kernel_launch: hipFuncSetAttribute failed\n"); grid = -1; return; }
        if (hipOccupancyMaxActiveBlocksPerMultiprocessor(&per_cu, (const void*)enc_fwd, NWAVES * 64, LDS_BYTES) != hipSuccess || per_cu < 1) fprintf(stderr, "kernel_launch: note: occupancy query reports %d workgroups per CU\n", per_cu);
        (void)hipGetLastError();
        grid = cus;
    }
    if (grid < 0) return;
    if (hipMemsetAsync((char*)d_ws + WS_CTL, 0, CTL_ZERO_BYTES, stream) != hipSuccess) { fprintf(stderr, "kernel_launch: hipMemsetAsync failed\n"); return; }
    Args a{};
    for (int i = 0; i < 24; ++i) a.in[i] = (const float*)d_in[i];
    a.out = (float*)d_out; a.ws = (unsigned char*)d_ws;
    constexpr int NPH_RUN = (MK_LAST_PHASE < 26) ? NPHASE + 1 : NPHASE;
#if MK_PER_PHASE
    for (int p = 0; p < NPH_RUN; ++p) { if (p < NPHASE && p > MK_LAST_PHASE) continue; a.ph_lo = p; a.ph_hi = p + 1;
        hipLaunchKernelGGL(enc_fwd, dim3(grid), dim3(NWAVES * 64), LDS_BYTES, stream, a); }
#else
    a.ph_lo = 0; a.ph_hi = NPH_RUN;
    hipLaunchKernelGGL(enc_fwd, dim3(grid), dim3(NWAVES * 64), LDS_BYTES, stream, a);
#endif
    const hipError_t le = hipPeekAtLastError();
    if (le != hipSuccess) fprintf(stderr, "kernel_launch: launch failed: %s\n", hipGetErrorName(le));
}
```

```cpp
#include <hip/hip_runtime.h>
#include <cstdio>

namespace pg8 {
#define PG8_LAS __attribute__((address_space(3)))
typedef unsigned short bf16_t;
typedef short bf16x8 __attribute__((ext_vector_type(8)));
typedef float f32x4 __attribute__((ext_vector_type(4)));
typedef float f32x2 __attribute__((ext_vector_type(2)));
typedef unsigned u32x4 __attribute__((ext_vector_type(4)));
typedef unsigned u32x2 __attribute__((ext_vector_type(2)));
typedef int v4i32 __attribute__((ext_vector_type(4)));
typedef int v8i32 __attribute__((ext_vector_type(8)));
constexpr int BM = 256, BK = 64, HALF = 128, HTB = HALF * BK * 2  , STAGE_BYTES = 8 * HTB, NXCD = 8;

__host__ __device__ __forceinline__ int lds_byte(int r, int c) { const int st = (r >> 4) * 2 + (c >> 5), rr = r & 15, cc = c & 31, ob = rr * 64 + cc * 2; return st * 1024 + (ob ^ (((ob >> 9) & 1) << 5)); }
__host__ __device__ __forceinline__ void stage_rc(int b, int& R, int& C) { const int st = b / 1024, sb = b % 1024, swz = sb ^ (((sb >> 9) & 1) << 5); R = (st >> 1) * 16 + swz / 64; C = (st & 1) * 32 + (swz % 64) / 2; }
__host__ __device__ __forceinline__ int perm32(int rho) { const int n = rho >> 4, i = rho & 15; return 8 * (i >> 2) + 4 * n + (i & 3); }

struct Unit { int pm, pn; };
struct Gemm { const bf16_t* A; const bf16_t* Bt; int M, N, K; };

struct StaticOrder {
    int nM, nN, nwg, G, c, wgm;
    __host__ __device__ void init(int M, int N, int G_, int c_, int wgm_ = 2) { nM = M / BM; nN = N / BM; nwg = nM * nN; G = G_; c = c_; wgm = wgm_; }
    __host__ __device__ bool next(int i, Unit& u) const {
        const long L = (long)i * G + c; if (L >= nwg) return false;
        int wgid = (int)L; { const int q = nwg / NXCD, r = nwg % NXCD, xcd = wgid % NXCD, off = wgid / NXCD; wgid = (xcd < r ? xcd * (q + 1) : r * (q + 1) + (xcd - r) * q) + off; }
        const int nig = wgm * nN, gid = wgid / nig, fm = gid * wgm, gsz = (nM - fm) < wgm ? (nM - fm) : wgm;
        const int w = wgid % nig;
        if (gsz == wgm && (wgm & (wgm - 1)) == 0) { u.pm = fm + (w & (wgm - 1)); u.pn = w >> __builtin_ctz(wgm); }
        else { u.pm = fm + (w % gsz); u.pn = w / gsz; }
        return true;
    }
    static constexpr bool PUBD = false;
    __device__ __forceinline__ size_t b_off(const Unit&) const { return 0; }
    __device__ __forceinline__ void a_ready(const Unit&) const {}
    __device__ __forceinline__ void done(const Unit&) const {}
    __device__ __forceinline__ void publish(int) const {}
};
template <bool PUB, bool GATE> struct MoeOrderT : StaticOrder {
    const PG8_LAS unsigned* tab; size_t estride; unsigned* cnt; unsigned need; unsigned* tmo;
    __device__ __forceinline__ size_t b_off(const Unit& u) const {
        const unsigned e = (unsigned)__builtin_amdgcn_readfirstlane((int)tab[u.pm]);
        return (size_t)e * estride;
    }
    __device__ __forceinline__ void a_ready(const Unit& u) const {
        if constexpr (GATE) {
            if (threadIdx.x < 64) {
                const unsigned long long t0 = __builtin_amdgcn_s_memrealtime(); unsigned polls = 0;
                while ((unsigned)__builtin_amdgcn_readfirstlane((int)__hip_atomic_load(cnt + 64 * u.pm, __ATOMIC_RELAXED, __HIP_MEMORY_SCOPE_AGENT)) < need) {
                    if ((++polls & 255u) == 0u && __builtin_amdgcn_readfirstlane((int)__hip_atomic_load(tmo, __ATOMIC_RELAXED, __HIP_MEMORY_SCOPE_AGENT)) != 0) break;
                    if (__builtin_amdgcn_s_memrealtime() - t0 > 2000000ull) { if (threadIdx.x == 0) __hip_atomic_store(tmo, 1u, __ATOMIC_RELAXED, __HIP_MEMORY_SCOPE_AGENT); break; }
                    __builtin_amdgcn_s_sleep(2); }
                __builtin_amdgcn_fence(__ATOMIC_ACQUIRE, "agent");
                asm volatile("s_waitcnt vmcnt(0)" ::: "memory");
            }
            asm volatile("" ::: "memory"); __builtin_amdgcn_s_barrier(); asm volatile("" ::: "memory");
        }
    }
    static constexpr bool PUBD = PUB;
    __device__ __forceinline__ void done(const Unit&) const {}
    __device__ __forceinline__ void publish(int pm) const { if constexpr (PUB) { if ((threadIdx.x & 63) == 0) __hip_atomic_fetch_add(cnt + 64 * pm, 1u, __ATOMIC_RELAXED, __HIP_MEMORY_SCOPE_AGENT); } }
};
typedef MoeOrderT<false, false> MoeOrder;

__device__ __forceinline__ unsigned cvt_pk_bf16(float lo, float hi) { unsigned r; asm volatile("v_cvt_pk_bf16_f32 %0, %1, %2" : "=v"(r) : "v"(lo), "v"(hi)); return r; }
__device__ __forceinline__ float bf_lo(unsigned w) { return __uint_as_float(w << 16); }
__device__ __forceinline__ float bf_hi(unsigned w) { return __uint_as_float(w & 0xffff0000u); }
__device__ __forceinline__ float sigmoidf_fast(float x) { return __builtin_amdgcn_rcpf(1.0f + __builtin_amdgcn_exp2f(x * -1.4426950408889634f)); }
__device__ __forceinline__ float siluf_fast(float x) { return x * sigmoidf_fast(x); }
__device__ __forceinline__ float gelu_tanh_fast(float x) { return x * sigmoidf_fast(1.5957691216057308f * (x + 0.044715f * x * x * x)); }
__device__ __forceinline__ f32x4 exp2_4(f32x4 x) { return (f32x4){__builtin_amdgcn_exp2f(x[0]), __builtin_amdgcn_exp2f(x[1]), __builtin_amdgcn_exp2f(x[2]), __builtin_amdgcn_exp2f(x[3])}; }
__device__ __forceinline__ f32x4 rcp_4(f32x4 x) { return (f32x4){__builtin_amdgcn_rcpf(x[0]), __builtin_amdgcn_rcpf(x[1]), __builtin_amdgcn_rcpf(x[2]), __builtin_amdgcn_rcpf(x[3])}; }
__device__ __forceinline__ f32x4 sigmoid_4(f32x4 x) { return rcp_4(exp2_4(x * -1.4426950408889634f) + 1.0f); }
__device__ __forceinline__ f32x4 gelu_tanh_4(f32x4 x) { return x * sigmoid_4((x * x * 0.044715f + 1.0f) * x * 1.5957691216057308f); }
#ifndef GEMM_BF16_ASM
#define GEMM_BF16_ASM 0
#endif
#ifndef GEMM_ZERO_C
#define GEMM_ZERO_C 1
#endif
#ifndef GLU_DEFER_STORES
#define GLU_DEFER_STORES 0
#endif
#ifndef GEMM_PRIO
#define GEMM_PRIO 1
#endif
#ifndef EPI_NT
#define EPI_NT 0
#endif
#ifndef GLU_T21
#define GLU_T21 0
#endif
#ifndef GLU_STAGE_STORES
#define GLU_STAGE_STORES 0
#endif
constexpr float RMS_EPS = 1e-6f;
constexpr int SSQ_M = 16384;
__device__ __forceinline__ float xor16_add(float v) { float a = v, b = v; asm volatile("s_nop 1\n\tv_permlane16_swap_b32 %0, %1" : "+v"(a), "+v"(b)); return a + b; }
__device__ __forceinline__ float xor32_add(float v) { float a = v, b = v; asm volatile("s_nop 1\n\tv_permlane32_swap_b32 %0, %1" : "+v"(a), "+v"(b)); return a + b; }
template <int CTRL> __device__ __forceinline__ float dpp_f(float v) { return __uint_as_float((unsigned)__builtin_amdgcn_update_dpp(0, (int)__float_as_uint(v), CTRL, 0xF, 0xF, true)); }
__device__ __forceinline__ float wave_sum_valu(float v) {
    v += dpp_f<0xB1>(v); v += dpp_f<0x4E>(v); v += dpp_f<0x141>(v); v += dpp_f<0x140>(v); v = xor16_add(v); return xor32_add(v); }
template <int OFF> __device__ __forceinline__ float xor_get(float x, int lane) {
    if constexpr (OFF == 32) { const auto r = __builtin_amdgcn_permlane32_swap(__float_as_uint(x), __float_as_uint(x), false, false); return __uint_as_float((lane & 32) ? r[0] : r[1]); }
    else if constexpr (OFF == 16) { const auto r = __builtin_amdgcn_permlane16_swap(__float_as_uint(x), __float_as_uint(x), false, false); return __uint_as_float((lane & 16) ? r[0] : r[1]); }
    else if constexpr (OFF == 8) return dpp_f<0x128>(x);
    else if constexpr (OFF == 4) { const float up = dpp_f<0x104>(x), dn = dpp_f<0x114>(x); return (lane & 4) ? dn : up; }
    else if constexpr (OFF == 2) return dpp_f<0x4E>(x);
    else return dpp_f<0xB1>(x);
}
template <class T> __device__ __forceinline__ void st_out(T* p, const T v) { if constexpr (EPI_NT != 0) __builtin_nontemporal_store(v, p); else *p = v; }
__device__ __forceinline__ float rstd_pf(float pf) { const float s = xor32_add(xor16_add(pf)); return __builtin_amdgcn_rsqf(s * (1.0f / 1024.0f) + RMS_EPS); }
struct NoState {};
#define PG8_NO_STATE typedef NoState State; __device__ __forceinline__ void init(State&) const {} __device__ __forceinline__ void flush(State&, int, int, int, int) const {}
template <int IMM> __device__ __forceinline__ float ld_pf(const float* base, unsigned voff) { float v; asm volatile("global_load_dword %0, %1, %2 offset:%3" : "=v"(v) : "v"(voff), "s"(base), "n"(IMM) : "memory"); return v; }
#define PG8_PF_ROWS(base, idx0) do { const unsigned voff_ = (unsigned)(idx0) * 4u; \
    pf[0] = ld_pf<0>(base, voff_); pf[1] = ld_pf<64>(base, voff_); pf[2] = ld_pf<128>(base, voff_); pf[3] = ld_pf<192>(base, voff_); \
    pf[4] = ld_pf<HALF * 4>(base, voff_); pf[5] = ld_pf<HALF * 4 + 64>(base, voff_); pf[6] = ld_pf<HALF * 4 + 128>(base, voff_); pf[7] = ld_pf<HALF * 4 + 192>(base, voff_); } while (0)
__device__ __forceinline__ u32x2 pack8_fp8(const f32x4 a, const f32x4 b) {
    int lo = 0, hi = 0; lo = __builtin_amdgcn_cvt_pk_fp8_f32(a[0], a[1], lo, false); lo = __builtin_amdgcn_cvt_pk_fp8_f32(a[2], a[3], lo, true);
    hi = __builtin_amdgcn_cvt_pk_fp8_f32(b[0], b[1], hi, false); hi = __builtin_amdgcn_cvt_pk_fp8_f32(b[2], b[3], hi, true); u32x2 w; w.x = (unsigned)lo; w.y = (unsigned)hi; return w; }
constexpr float W8_SCALE = 64.0f, W8_INV = 1.0f / 64.0f;
__device__ __forceinline__ u32x4 pack8(const f32x4 a, const f32x4 b) { u32x4 w; w.x = cvt_pk_bf16(a[0], a[1]); w.y = cvt_pk_bf16(a[2], a[3]); w.z = cvt_pk_bf16(b[0], b[1]); w.w = cvt_pk_bf16(b[2], b[3]); return w; }

template <bool SC8 = false> struct EpiEvenInT {
    static constexpr bool PERM = true, AFTER_DRAIN = false, IDEM = true;
    PG8_NO_STATE
    bf16_t* za; bf16_t* glu; const float* ssq; f32x2* lna;
    __device__ __forceinline__ void prefetch(const Unit& u, int wr, int wc, int fr, int fq, float (&pf)[8]) const { PG8_PF_ROWS(ssq, fq * SSQ_M + u.pm * BM + wr * 64 + fr); }
    __device__ __forceinline__ void operator()(const f32x4 (&acc)[2][2][4][2], const Unit& u, int wr, int wc, int fr, int fq, const float (&pf)[8], State& est) const {
        const int row0 = u.pm * BM + wr * 64 + fr;
        if (u.pn < 4) {
#pragma unroll
            for (int ai = 0; ai < 2; ++ai)
#pragma unroll
                for (int m = 0; m < 4; ++m) { const int row = row0 + ai * HALF + m * 16; const float r = rstd_pf(pf[ai * 4 + m]) * (SC8 ? W8_INV : 1.0f); bf16_t* rowp = za + (size_t)row * 1024 + u.pn * 256 + wc * 32 + 8 * fq; float s = 0.f, q = 0.f;
#pragma unroll
                    for (int bj = 0; bj < 2; ++bj) { f32x4 v0 = acc[ai][bj][m][0] * r, v1 = acc[ai][bj][m][1] * r;
#pragma unroll
                        for (int j = 0; j < 1; ++j) { v0 = gelu_tanh_4(v0); v1 = gelu_tanh_4(v1); const f32x4 sv = v0 + v1, qv = v0 * v0 + v1 * v1; s += (sv[0] + sv[1]) + (sv[2] + sv[3]); q += (qv[0] + qv[1]) + (qv[2] + qv[3]); }
                        *(u32x4*)(rowp + bj * HALF) = pack8(v0, v1); }
                    if (u.pn >= 2) { s = xor32_add(xor16_add(s)); q = xor32_add(xor16_add(q));
                        if (fq == 0) lna[(size_t)((u.pn - 2) * 4 + wc) * SSQ_M + row] = (f32x2){s, q}; } }
        } else {
            const int q = u.pn - 4;
#pragma unroll
            for (int ai = 0; ai < 2; ++ai)
#pragma unroll
                for (int m = 0; m < 4; ++m) { const int row = row0 + ai * HALF + m * 16; const float r = rstd_pf(pf[ai * 4 + m]) * (SC8 ? W8_INV : 1.0f); bf16_t* rowp = glu + (size_t)row * 512 + q * 128 + wc * 32 + 8 * fq;
                    f32x4 o0, o1;
#pragma unroll
                    for (int j = 0; j < 1; ++j) { o0 = (acc[ai][0][m][0] * r) * sigmoid_4(acc[ai][1][m][0] * r); o1 = (acc[ai][0][m][1] * r) * sigmoid_4(acc[ai][1][m][1] * r); }
                    *(u32x4*)rowp = pack8(o0, o1); }
        }
    }
};
typedef EpiEvenInT<false> EpiEvenIn;
template <bool SC8 = false> struct EpiOddInT {
    static constexpr bool PERM = true, AFTER_DRAIN = false, IDEM = true;
    PG8_NO_STATE
    bf16_t* gb; bf16_t* cv; const float* ssq;
    __device__ __forceinline__ void prefetch(const Unit& u, int wr, int wc, int fr, int fq, float (&pf)[8]) const { PG8_PF_ROWS(ssq, fq * SSQ_M + u.pm * BM + wr * 64 + fr); }
    __device__ __forceinline__ void operator()(const f32x4 (&acc)[2][2][4][2], const Unit& u, int wr, int wc, int fr, int fq, const float (&pf)[8], State& est) const {
        const int row0 = u.pm * BM + wr * 64 + fr;
        if (u.pn < 4) {
#pragma unroll
            for (int ai = 0; ai < 2; ++ai)
#pragma unroll
                for (int m = 0; m < 4; ++m) { const int row = row0 + ai * HALF + m * 16; const float r = rstd_pf(pf[ai * 4 + m]) * (SC8 ? W8_INV : 1.0f); bf16_t* rowp = gb + (size_t)row * 1024 + u.pn * 256 + wc * 32 + 8 * fq;
#pragma unroll
                    for (int bj = 0; bj < 2; ++bj) *(u32x4*)(rowp + bj * HALF) = pack8(acc[ai][bj][m][0] * r, acc[ai][bj][m][1] * r); }
        } else {
            const int q = u.pn - 4;
#pragma unroll
            for (int ai = 0; ai < 2; ++ai)
#pragma unroll
                for (int m = 0; m < 4; ++m) { const int row = row0 + ai * HALF + m * 16; const float r = rstd_pf(pf[ai * 4 + m]) * (SC8 ? W8_INV : 1.0f), r2 = r * r; bf16_t* rowp = cv + (size_t)row * 1024 + q * 128 + wc * 32 + 8 * fq;
                    *(u32x4*)rowp = pack8(acc[ai][0][m][0] * acc[ai][1][m][0] * r2, acc[ai][0][m][1] * acc[ai][1][m][1] * r2); }
        }
    }
};
typedef EpiOddInT<false> EpiOddIn;
template <bool DIRECT, bool OUT8, bool PUB = false> struct EpiGlu {
    static constexpr bool PERM = true, AFTER_DRAIN = false, IDEM = true;
    void* out; int ldo; const float* rs; float sc; PG8_LAS unsigned char* stg;
    static constexpr bool DEFER = OUT8 && !PUB && (GLU_DEFER_STORES != 0);
    struct State { u32x2 d[8]; int pm, pn; bool valid; };
    __device__ __forceinline__ void init(State& s) const { s.valid = false; s.pm = 0; s.pn = 0;
#pragma unroll
        for (int i = 0; i < 8; ++i) s.d[i] = (u32x2){0u, 0u}; }
    __device__ __forceinline__ void flush(State& s, int wr, int wc, int fr, int fq) const {
        if constexpr (DEFER) { if (s.valid) {
#pragma unroll
            for (int i = 0; i < 8; ++i) { const int row = s.pm * BM + wr * 64 + fr + (i >> 2) * HALF + (i & 3) * 16; *(u32x2*)((unsigned char*)out + (size_t)row * ldo + s.pn * 128 + wc * 32 + 8 * fq) = s.d[i]; }
            s.valid = false; } } }
    __device__ __forceinline__ void prefetch(const Unit& u, int wr, int wc, int fr, int fq, float (&pf)[8]) const { PG8_PF_ROWS(rs, (DIRECT ? 0 : fq * SSQ_M) + u.pm * BM + wr * 64 + fr); }
    __device__ __forceinline__ void glu8(const f32x4 (&acc)[2][2][4][2], int ai, int m, float r, f32x4& o0, f32x4& o1) const {
        const float rl = r * -1.4426950408889634f, q = __builtin_amdgcn_rcpf(r * r);
        const f32x4 d0 = exp2_4(acc[ai][0][m][0] * rl) * q + q, d1 = exp2_4(acc[ai][0][m][1] * rl) * q + q;
        o0 = (acc[ai][0][m][0] * acc[ai][1][m][0]) * rcp_4(d0); o1 = (acc[ai][0][m][1] * acc[ai][1][m][1]) * rcp_4(d1); }
    __device__ __forceinline__ void probe_math(const f32x4 (&acc)[2][2][4][2], const float (&pf)[8]) const {
#pragma unroll
        for (int ai = 0; ai < 2; ++ai)
#pragma unroll
            for (int m = 0; m < 4; ++m) { const float r = (DIRECT ? pf[ai * 4 + m] : rstd_pf(pf[ai * 4 + m])) * sc; f32x4 o0, o1; glu8(acc, ai, m, r, o0, o1);
                if constexpr (OUT8) { const u32x2 w = pack8_fp8(o0, o1); asm volatile("" :: "v"(w.x), "v"(w.y)); } else { const u32x4 w = pack8(o0, o1); asm volatile("" :: "v"(w.x), "v"(w.y), "v"(w.z), "v"(w.w)); } } }
    __device__ __forceinline__ void operator()(const f32x4 (&acc)[2][2][4][2], const Unit& u, int wr, int wc, int fr, int fq, const float (&pf)[8], State& est) const {
        const int row0 = u.pm * BM + wr * 64 + fr;
        if constexpr (PUB) {
#pragma unroll
            for (int ai = 0; ai < 2; ++ai)
#pragma unroll
                for (int m = 0; m < 4; ++m) { const int row = row0 + ai * HALF + m * 16; const float r = (DIRECT ? pf[ai * 4 + m] : rstd_pf(pf[ai * 4 + m])) * sc; const size_t off = (size_t)row * ldo + u.pn * 128 + wc * 32 + 8 * fq;
                    f32x4 o0, o1; glu8(acc, ai, m, r, o0, o1); const u32x2 w = pack8_fp8(o0, o1);
                    __hip_atomic_store((unsigned long long*)((unsigned char*)out + off), ((unsigned long long)w.y << 32) | w.x, __ATOMIC_RELAXED, __HIP_MEMORY_SCOPE_AGENT); }
        } else if constexpr (DEFER) {
            flush(est, wr, wc, fr, fq);
#pragma unroll
            for (int ai = 0; ai < 2; ++ai)
#pragma unroll
                for (int m = 0; m < 4; ++m) { const float r = (DIRECT ? pf[ai * 4 + m] : rstd_pf(pf[ai * 4 + m])) * sc; f32x4 o0, o1; glu8(acc, ai, m, r, o0, o1); est.d[ai * 4 + m] = pack8_fp8(o0, o1); }
            est.pm = u.pm; est.pn = u.pn; est.valid = true;
        } else if constexpr (OUT8 && (GLU_T21 != 0)) {
#pragma unroll
            for (int ai = 0; ai < 2; ++ai)
#pragma unroll
                for (int k = 0; k < 2; ++k) { u32x2 X, Y;
#pragma unroll
                    for (int q = 0; q < 4; ++q) { const int m = 2 * k + (q >> 1), n = q & 1; const float r = (DIRECT ? pf[ai * 4 + m] : rstd_pf(pf[ai * 4 + m])) * sc;
                        const f32x4 t = acc[ai][0][m][n] * r, o = (t * sigmoid_4(t)) * (acc[ai][1][m][n] * r);
                        int w = 0; w = __builtin_amdgcn_cvt_pk_fp8_f32(o[0], o[1], w, false); w = __builtin_amdgcn_cvt_pk_fp8_f32(o[2], o[3], w, true);
                        unsigned wu = (unsigned)w; asm volatile("" : "+v"(wu));
                        if (q == 0) X.x = wu; else if (q == 1) X.y = wu; else if (q == 2) Y.x = wu; else Y.y = wu; }
                    const auto s0 = __builtin_amdgcn_permlane16_swap(X.x, Y.x, false, false), s1 = __builtin_amdgcn_permlane16_swap(X.y, Y.y, false, false);
                    u32x4 w; w.x = s0[0]; w.y = s1[0]; w.z = s0[1]; w.w = s1[1];
                    const int row = row0 + ai * HALF + (2 * k + (fq & 1)) * 16;
                    *(u32x4*)((unsigned char*)out + (size_t)row * ldo + u.pn * 128 + wc * 32 + 16 * (fq >> 1)) = w; }
        } else if constexpr (!GLU_STAGE_STORES) {
#pragma unroll
            for (int ai = 0; ai < 2; ++ai)
#pragma unroll
                for (int m = 0; m < 4; ++m) { const int row = row0 + ai * HALF + m * 16; const float r = (DIRECT ? pf[ai * 4 + m] : rstd_pf(pf[ai * 4 + m])) * sc; const size_t off = (size_t)row * ldo + u.pn * 128 + wc * 32 + 8 * fq;
                    f32x4 o0, o1; glu8(acc, ai, m, r, o0, o1);
                    if constexpr (OUT8) st_out((u32x2*)((unsigned char*)out + off), pack8_fp8(o0, o1)); else st_out((u32x4*)((bf16_t*)out + off), pack8(o0, o1)); }
        } else if constexpr (OUT8) {
            const int w8 = wr * 4 + wc, l = fr + 16 * fq;
#pragma unroll
            for (int ai = 0; ai < 2; ++ai) {
#pragma unroll
                for (int m = 0; m < 4; ++m) { const float r = (DIRECT ? pf[ai * 4 + m] : rstd_pf(pf[ai * 4 + m])) * sc; f32x4 o0, o1; glu8(acc, ai, m, r, o0, o1);
                    *(PG8_LAS u32x2*)(stg + (wr * 64 + m * 16 + fr) * 144 + wc * 32 + 8 * fq) = pack8_fp8(o0, o1); }
                asm volatile("s_waitcnt lgkmcnt(0)" ::: "memory"); __builtin_amdgcn_s_barrier(); asm volatile("" ::: "memory");
#pragma unroll
                for (int t = 0; t < 2; ++t) { const int rl = 16 * w8 + 8 * t + (l >> 3), c = l & 7; const u32x4 v = *(const PG8_LAS u32x4*)(stg + rl * 144 + 16 * c);
                    *(u32x4*)((unsigned char*)out + (size_t)(u.pm * BM + ai * HALF + rl) * ldo + u.pn * 128 + 16 * c) = v; }
                asm volatile("s_waitcnt lgkmcnt(0)" ::: "memory"); __builtin_amdgcn_s_barrier(); asm volatile("" ::: "memory");
            }
        } else {
            const int w8 = wr * 4 + wc, l = fr + 16 * fq;
#pragma unroll
            for (int ai = 0; ai < 2; ++ai)
#pragma unroll
                for (int mh = 0; mh < 2; ++mh) {
#pragma unroll
                    for (int mm = 0; mm < 2; ++mm) { const int m = 2 * mh + mm; const float r = (DIRECT ? pf[ai * 4 + m] : rstd_pf(pf[ai * 4 + m])) * sc; f32x4 o0, o1; glu8(acc, ai, m, r, o0, o1);
                        *(PG8_LAS u32x4*)(stg + (wr * 32 + mm * 16 + fr) * 272 + wc * 64 + 16 * fq) = pack8(o0, o1); }
                    asm volatile("s_waitcnt lgkmcnt(0)" ::: "memory"); __builtin_amdgcn_s_barrier(); asm volatile("" ::: "memory");
#pragma unroll
                    for (int t = 0; t < 2; ++t) { const int rl = 8 * w8 + 4 * t + (l >> 4), c = l & 15; const u32x4 v = *(const PG8_LAS u32x4*)(stg + rl * 272 + 16 * c);
                        const int grow = u.pm * BM + ai * HALF + (rl >> 5) * 64 + mh * 32 + (rl & 31);
                        *(u32x4*)((bf16_t*)out + (size_t)grow * ldo + u.pn * 128 + 8 * c) = v; }
                    asm volatile("s_waitcnt lgkmcnt(0)" ::: "memory"); __builtin_amdgcn_s_barrier(); asm volatile("" ::: "memory");
                }
        }
    }
};
template <bool X8, bool SC8 = false> struct EpiRes {
    static constexpr bool PERM = true, AFTER_DRAIN = false, IDEM = false;
    PG8_NO_STATE
    bf16_t* xb; float* ssq_out; unsigned char* x8; PG8_LAS float* red;
    __device__ __forceinline__ void prefetch(const Unit&, int, int, int, int, float (&)[8]) const {}
    __device__ __forceinline__ void operator()(const f32x4 (&acc)[2][2][4][2], const Unit& u, int wr, int wc, int fr, int fq, const float (&pf)[8], State& est) const {
        const int row0 = u.pm * BM + wr * 64 + fr; bf16_t* const xb_ = xb; float* const so_ = ssq_out; constexpr float sc_ = SC8 ? W8_INV : 1.0f; unsigned char* const x8_ = x8; PG8_LAS float* const red_ = red;
#pragma unroll
        for (int ai = 0; ai < 2; ++ai)
#pragma unroll
            for (int m = 0; m < 4; ++m) { const int row = row0 + ai * HALF + m * 16; const size_t off = (size_t)row * 1024 + u.pn * 256 + wc * 32 + 8 * fq; bf16_t* rowp = xb_ + off; float s = 0.f;
#pragma unroll
                for (int bj = 0; bj < 2; ++bj) { const u32x4 old = *(const u32x4*)(rowp + bj * HALF); const f32x4 a0 = acc[ai][bj][m][0] * sc_, a1 = acc[ai][bj][m][1] * sc_;
                    f32x4 n0, n1; n0[0] = bf_lo(old.x) + a0[0]; n0[1] = bf_hi(old.x) + a0[1]; n0[2] = bf_lo(old.y) + a0[2]; n0[3] = bf_hi(old.y) + a0[3];
                    n1[0] = bf_lo(old.z) + a1[0]; n1[1] = bf_hi(old.z) + a1[1]; n1[2] = bf_lo(old.w) + a1[2]; n1[3] = bf_hi(old.w) + a1[3];
                    s += (n0[0] * n0[0] + n0[1] * n0[1]) + (n0[2] * n0[2] + n0[3] * n0[3]) + (n1[0] * n1[0] + n1[1] * n1[1]) + (n1[2] * n1[2] + n1[3] * n1[3]);
                    *(u32x4*)(rowp + bj * HALF) = pack8(n0, n1);
                    if constexpr (X8) *(u32x2*)(x8_ + off + bj * HALF) = pack8_fp8(n0, n1); }
                s = xor32_add(xor16_add(s));
                if (fq == 0) red_[(ai * HALF + wr * 64 + m * 16 + fr) * 4 + wc] = s; }
        asm volatile("s_waitcnt lgkmcnt(0)" ::: "memory"); __builtin_amdgcn_s_barrier(); asm volatile("" ::: "memory");
        { const int l = fr + 16 * fq; if (l < 32) { const int q = wc * 32 + l, rl = (q >> 6) * HALF + wr * 64 + (q & 63); const f32x4 v = *(const PG8_LAS f32x4*)(red_ + rl * 4);
            so_[(size_t)u.pn * SSQ_M + u.pm * BM + rl] = (v[0] + v[1]) + (v[2] + v[3]); } }
    }
};
template <class T> struct is_glu { static constexpr bool v = false; };
template <bool A, bool B, bool C> struct is_glu<EpiGlu<A, B, C>> { static constexpr bool v = true; };
constexpr float OG8_SCALE = 16.0f, OG8_INV = 1.0f / 16.0f;
template <bool OG8> struct EpiMoeDown {
    static constexpr bool PERM = true, AFTER_DRAIN = false, IDEM = true;
    PG8_NO_STATE
    void* og; const float* gate; float sc;
    __device__ __forceinline__ void prefetch(const Unit& u, int wr, int wc, int fr, int fq, float (&pf)[8]) const { PG8_PF_ROWS(gate, u.pm * BM + wr * 64 + fr); }
    __device__ __forceinline__ void operator()(const f32x4 (&acc)[2][2][4][2], const Unit& u, int wr, int wc, int fr, int fq, const float (&pf)[8], State& est) const {
        const int row0 = u.pm * BM + wr * 64 + fr;
#pragma unroll
        for (int ai = 0; ai < 2; ++ai)
#pragma unroll
            for (int m = 0; m < 4; ++m) { const int row = row0 + ai * HALF + m * 16; const float r = pf[ai * 4 + m] * sc * (OG8 ? OG8_SCALE : 1.0f); const size_t off = (size_t)row * 1024 + u.pn * 256 + wc * 32 + 8 * fq;
#pragma unroll
                for (int bj = 0; bj < 2; ++bj) { if constexpr (OG8) st_out((u32x2*)((unsigned char*)og + off + bj * HALF), pack8_fp8(acc[ai][bj][m][0] * r, acc[ai][bj][m][1] * r));
                                                else *(u32x4*)((bf16_t*)og + off + bj * HALF) = pack8(acc[ai][bj][m][0] * r, acc[ai][bj][m][1] * r); } }
    }
};

template <class Epi, class Sched, bool ALIGN_EPI = false, bool SP2 = false, bool F8 = false, bool FK = false>
__device__ __forceinline__ void gemm_phase(PG8_LAS unsigned char* lds, const Gemm g, const Sched& S, const Epi& E) {
    int tid_ = threadIdx.x; asm volatile("" : "+v"(tid_));
    const int tid = tid_, wid = __builtin_amdgcn_readfirstlane(tid >> 6), lane = tid & 63, wr = wid >> 2, wc = wid & 3, fr = lane & 15, fq = lane >> 4;
    constexpr bool BF16_ASM = (GEMM_BF16_ASM != 0);
    constexpr bool ZERO_C = (GEMM_ZERO_C != 0) && (F8 || BF16_ASM);
    const int K = F8 ? g.K / 2 : g.K, nt = K / BK;
    unsigned voffA[2], voffB[2];
#pragma unroll
    for (int i = 0; i < 2; ++i) { int R, C; stage_rc(tid * 16 + i * 8192, R, C); const int Rb = Epi::PERM ? ((R & ~31) + perm32(R & 31)) : R;
        voffA[i] = (unsigned)(R * K + C) * 2u; voffB[i] = (unsigned)(Rb * K + C) * 2u; }
    constexpr bool fk = FK;
    const size_t kstep = fk ? (size_t)0 : (size_t)(BK * 2);
    const size_t hstep = (size_t)HALF * K * 2;
    const size_t tstep = 2 * hstep;
    const unsigned ldsw = (unsigned)wid * 1024u;
    const int aoff = lds_byte(wr * 64 + fr, fq * 8), boff = lds_byte(wc * 32 + fr, fq * 8);
#define PG8_SA(b, h) (((b) * 2 + (h)) * HTB)
#define PG8_SB(b, h) ((4 + (b) * 2 + (h)) * HTB)
#ifndef PROBE_FKMODE
#define PROBE_FKMODE 0
#endif
#define PG8_STAGE(bufoff, gbase, voff) do { if constexpr (!(FK && PROBE_FKMODE >= 2)) _Pragma("unroll") for (int _i = 0; _i < 2; ++_i) \
        __builtin_amdgcn_global_load_lds((const unsigned*)((const char*)(gbase) + (voff)[_i]), (PG8_LAS unsigned*)(lds + (bufoff) + ldsw + _i * 8192), 16, 0, 0); } while (0)
#define PG8_LD16(off) (*(const PG8_LAS v4i32*)(lds + (off)))
#define PG8_LDA(dst, b, h) do { if constexpr (FK && PROBE_FKMODE == 3) { } else if constexpr (F8) { _Pragma("unroll") for (int m = 0; m < 4; ++m) dst##8[m] = __builtin_shufflevector(PG8_LD16(PG8_SA(b, h) + aoff + m * 2048), PG8_LD16(PG8_SA(b, h) + aoff + m * 2048 + 1024), 0, 1, 2, 3, 4, 5, 6, 7); } \
        else { _Pragma("unroll") for (int m = 0; m < 4; ++m) _Pragma("unroll") for (int k = 0; k < 2; ++k) dst[m][k] = *(const PG8_LAS bf16x8*)(lds + PG8_SA(b, h) + aoff + m * 2048 + k * 1024); } } while (0)
#define PG8_LDB(dst, b, h) do { if constexpr (FK && PROBE_FKMODE == 3) { } else if constexpr (F8) { _Pragma("unroll") for (int n = 0; n < 2; ++n) dst##8[n] = __builtin_shufflevector(PG8_LD16(PG8_SB(b, h) + boff + n * 2048), PG8_LD16(PG8_SB(b, h) + boff + n * 2048 + 1024), 0, 1, 2, 3, 4, 5, 6, 7); } \
        else { _Pragma("unroll") for (int n = 0; n < 2; ++n) _Pragma("unroll") for (int k = 0; k < 2; ++k) dst[n][k] = *(const PG8_LAS bf16x8*)(lds + PG8_SB(b, h) + boff + n * 2048 + k * 1024); } } while (0)
#define PG8_MMA(ai, bj, At, Bt) do { if constexpr (GEMM_PRIO != 0) __builtin_amdgcn_s_setprio(1); \
        if constexpr (FK && PROBE_FKMODE == 4) { } else if constexpr (F8) { _Pragma("unroll") for (int m = 0; m < 4; ++m) _Pragma("unroll") for (int n = 0; n < 2; ++n) \
            asm volatile("v_mfma_f32_16x16x128_f8f6f4 %0, %1, %2, %0" : "+v"(acc[ai][bj][m][n]) : "v"(Bt##8[n]), "v"(At##8[m])); } \
        else { _Pragma("unroll") for (int m = 0; m < 4; ++m) _Pragma("unroll") for (int n = 0; n < 2; ++n) _Pragma("unroll") for (int k = 0; k < 2; ++k) \
            { if constexpr (BF16_ASM) asm volatile("v_mfma_f32_16x16x32_bf16 %0, %1, %2, %0" : "+v"(acc[ai][bj][m][n]) : "v"(Bt[n][k]), "v"(At[m][k])); else acc[ai][bj][m][n] = __builtin_amdgcn_mfma_f32_16x16x32_bf16(Bt[n][k], At[m][k], acc[ai][bj][m][n], 0, 0, 0); } } \
        if constexpr (GEMM_PRIO != 0) __builtin_amdgcn_s_setprio(0); } while (0)
#define PG8_MMAZ(ai, bj, At, Bt) do { if constexpr (!ZERO_C) { PG8_MMA(ai, bj, At, Bt); } else if (t != 0) { PG8_MMA(ai, bj, At, Bt); } else { if constexpr (GEMM_PRIO != 0) __builtin_amdgcn_s_setprio(1); \
        if constexpr (FK && PROBE_FKMODE == 4) { } else if constexpr (F8) { _Pragma("unroll") for (int m = 0; m < 4; ++m) _Pragma("unroll") for (int n = 0; n < 2; ++n) \
            asm volatile("v_mfma_f32_16x16x128_f8f6f4 %0, %1, %2, 0" : "=v"(acc[ai][bj][m][n]) : "v"(Bt##8[n]), "v"(At##8[m])); } \
        else { _Pragma("unroll") for (int m = 0; m < 4; ++m) _Pragma("unroll") for (int n = 0; n < 2; ++n) { \
            asm volatile("v_mfma_f32_16x16x32_bf16 %0, %1, %2, 0" : "=v"(acc[ai][bj][m][n]) : "v"(Bt[n][0]), "v"(At[m][0])); \
            asm volatile("v_mfma_f32_16x16x32_bf16 %0, %1, %2, %0" : "+v"(acc[ai][bj][m][n]) : "v"(Bt[n][1]), "v"(At[m][1])); } } \
        if constexpr (GEMM_PRIO != 0) __builtin_amdgcn_s_setprio(0); } } while (0)
#define PG8_RPRIO(p) do { if constexpr (GEMM_PRIO == 2) __builtin_amdgcn_s_setprio(p); } while (0)
#define PG8_WAIT_V(n) do { if constexpr (!(FK && PROBE_FKMODE >= 1)) asm volatile("s_waitcnt vmcnt(" #n ")" ::: "memory"); } while (0)
#define PG8_WAIT_L(n) asm volatile("s_waitcnt lgkmcnt(" #n ")" ::: "memory")
#define PG8_BAR __builtin_amdgcn_s_barrier()
#define PG8_SCHED __builtin_amdgcn_sched_barrier(0)
    Unit cur, nxt; int ui = 0;
    if (!S.next(0, cur)) return;
    f32x4 acc[2][2][4][2];
#pragma unroll
    for (int a = 0; a < 2; ++a)
#pragma unroll
        for (int b = 0; b < 2; ++b)
#pragma unroll
            for (int m = 0; m < 4; ++m)
#pragma unroll
                for (int n = 0; n < 2; ++n) { if constexpr (!ZERO_C || (FK && PROBE_FKMODE == 4)) acc[a][b][m][n] = (f32x4){0.f, 0.f, 0.f, 0.f}; }
    typename Epi::State est; E.init(est);
    int pend_pm = -1;
    float pf[8] = {0.f, 0.f, 0.f, 0.f, 0.f, 0.f, 0.f, 0.f};
    bf16x8 At[4][2], B0[2][2], B1[2][2]; v8i32 At8[4], B08[2], B18[2];
    if constexpr (FK && PROBE_FKMODE == 3) {
#pragma unroll
        for (int m = 0; m < 4; ++m) { asm volatile("" : "=v"(At8[m])); asm volatile("" : "=v"(At[m][0])); asm volatile("" : "=v"(At[m][1])); }
#pragma unroll
        for (int n = 0; n < 2; ++n) { asm volatile("" : "=v"(B08[n])); asm volatile("" : "=v"(B18[n])); asm volatile("" : "=v"(B0[n][0])); asm volatile("" : "=v"(B0[n][1])); asm volatile("" : "=v"(B1[n][0])); asm volatile("" : "=v"(B1[n][1])); }
    }
    const char* cA = (const char*)g.A + (fk ? (size_t)0 : (size_t)cur.pm * tstep); const char* cB = (const char*)g.Bt + (fk ? (size_t)0 : S.b_off(cur) + (size_t)cur.pn * tstep);
    S.a_ready(cur);
    if constexpr (SP2) {
        PG8_STAGE(PG8_SB(0, 0), cB, voffB); PG8_STAGE(PG8_SB(0, 1), cB + hstep, voffB); PG8_STAGE(PG8_SA(0, 0), cA, voffA); PG8_STAGE(PG8_SA(0, 1), cA + hstep, voffA);
        if (wr == 1) PG8_BAR;
        PG8_WAIT_V(2); PG8_BAR;
        PG8_STAGE(PG8_SB(1, 0), cB + kstep, voffB); PG8_STAGE(PG8_SA(1, 0), cA + kstep, voffA); PG8_STAGE(PG8_SB(1, 1), cB + hstep + kstep, voffB);
        PG8_WAIT_V(6); PG8_BAR;
    } else {
        PG8_STAGE(PG8_SB(0, 0), cB, voffB); PG8_STAGE(PG8_SA(0, 0), cA, voffA); PG8_STAGE(PG8_SB(0, 1), cB + hstep, voffB); PG8_STAGE(PG8_SA(0, 1), cA + hstep, voffA);
        if (wr == 1) PG8_BAR;
        PG8_WAIT_V(4); PG8_BAR;
        PG8_STAGE(PG8_SB(1, 0), cB + kstep, voffB); PG8_STAGE(PG8_SA(1, 0), cA + kstep, voffA); PG8_STAGE(PG8_SB(1, 1), cB + hstep + kstep, voffB);
        PG8_WAIT_V(6); PG8_BAR;
    }
    for (;;) {
        const bool has_next = S.next(ui + 1, nxt);
        const char* nA = (has_next && !fk) ? (const char*)g.A + (size_t)nxt.pm * tstep : cA; const char* nB = (has_next && !fk) ? (const char*)g.Bt + S.b_off(nxt) + (size_t)nxt.pn * tstep : cB;
        for (int t = 0; t < nt; t += 2) {
            const bool last = (t == nt - 2);
            const char* a1 = cA + (size_t)(t + 1) * kstep;
            const char* a2 = last ? nA : cA + (size_t)(t + 2) * kstep; const char* b2 = last ? nB : cB + (size_t)(t + 2) * kstep;
            const char* a3 = a2 + kstep; const char* b3 = b2 + kstep;
            if (last) { E.prefetch(cur, wr, wc, fr, fq, pf); if constexpr (Sched::PUBD) { if (pend_pm >= 0) { S.publish(pend_pm); pend_pm = -1; } } }
            if (last && has_next) S.a_ready(nxt);
            if constexpr (SP2) {
            PG8_RPRIO(2); PG8_LDB(B0, 0, 0); PG8_LDB(B1, 0, 1); PG8_SCHED; PG8_LDA(At, 0, 0); PG8_RPRIO(0); PG8_STAGE(PG8_SA(1, 1), a1 + hstep, voffA);
            PG8_WAIT_V(8); PG8_WAIT_L(0); PG8_BAR; PG8_MMAZ(0, 0, At, B0); PG8_MMAZ(0, 1, At, B1); PG8_BAR; PG8_SCHED;
            PG8_RPRIO(2); PG8_LDA(At, 0, 1); PG8_RPRIO(0); PG8_STAGE(PG8_SB(0, 0), b2, voffB); PG8_STAGE(PG8_SB(0, 1), b2 + hstep, voffB); PG8_STAGE(PG8_SA(0, 0), a2, voffA);
            PG8_WAIT_V(8); PG8_WAIT_L(0); PG8_BAR; PG8_MMAZ(1, 0, At, B0); PG8_MMAZ(1, 1, At, B1); PG8_BAR; PG8_SCHED;
            PG8_RPRIO(2); PG8_LDB(B0, 1, 0); PG8_LDB(B1, 1, 1); PG8_SCHED; PG8_LDA(At, 1, 0); PG8_RPRIO(0); PG8_STAGE(PG8_SA(0, 1), a2 + hstep, voffA);
            PG8_WAIT_V(8); PG8_WAIT_L(0); PG8_BAR; PG8_MMA(0, 0, At, B0); PG8_MMA(0, 1, At, B1); PG8_BAR; PG8_SCHED;
            PG8_RPRIO(2); PG8_LDA(At, 1, 1); PG8_RPRIO(0); PG8_STAGE(PG8_SB(1, 0), b3, voffB); PG8_STAGE(PG8_SB(1, 1), b3 + hstep, voffB); PG8_STAGE(PG8_SA(1, 0), a3, voffA);
            PG8_WAIT_V(8); PG8_WAIT_L(0); PG8_BAR; PG8_MMA(1, 0, At, B0); PG8_MMA(1, 1, At, B1); PG8_BAR; PG8_SCHED;
            } else {
            PG8_LDB(B0, 0, 0); PG8_SCHED; PG8_LDA(At, 0, 0); PG8_STAGE(PG8_SA(1, 1), a1 + hstep, voffA);
            PG8_WAIT_L(8); PG8_BAR; PG8_WAIT_L(0); PG8_MMAZ(0, 0, At, B0); PG8_BAR; PG8_SCHED;
            PG8_LDB(B1, 0, 1); PG8_STAGE(PG8_SB(0, 0), b2, voffB);
            PG8_BAR; PG8_WAIT_L(0); PG8_MMAZ(0, 1, At, B1); PG8_BAR;
            PG8_LDA(At, 0, 1); PG8_STAGE(PG8_SA(0, 0), a2, voffA);
            PG8_BAR; PG8_WAIT_L(0); PG8_MMAZ(1, 0, At, B0); PG8_BAR; PG8_SCHED;
            PG8_STAGE(PG8_SB(0, 1), b2 + hstep, voffB);
            PG8_WAIT_V(6); PG8_BAR; PG8_MMAZ(1, 1, At, B1); PG8_BAR;
            PG8_LDB(B0, 1, 0); PG8_SCHED; PG8_LDA(At, 1, 0); PG8_STAGE(PG8_SA(0, 1), a2 + hstep, voffA);
            PG8_WAIT_L(8); PG8_BAR; PG8_WAIT_L(0); PG8_MMA(0, 0, At, B0); PG8_BAR; PG8_SCHED;
            PG8_LDB(B1, 1, 1); PG8_STAGE(PG8_SB(1, 0), b3, voffB);
            PG8_BAR; PG8_WAIT_L(0); PG8_MMA(0, 1, At, B1); PG8_BAR;
            PG8_LDA(At, 1, 1); PG8_STAGE(PG8_SA(1, 0), a3, voffA);
            PG8_BAR; PG8_WAIT_L(0); PG8_MMA(1, 0, At, B0); PG8_BAR; PG8_SCHED;
            PG8_STAGE(PG8_SB(1, 1), b3 + hstep, voffB);
            PG8_WAIT_V(6); PG8_BAR; PG8_MMA(1, 1, At, B1); PG8_BAR;
            }
        }
        if constexpr (ALIGN_EPI) { if (wr == 0) PG8_BAR; }
        if constexpr (F8 || BF16_ASM) {
#define PG8_A4(a, b) "+v"(acc[a][b][0][0]), "+v"(acc[a][b][0][1]), "+v"(acc[a][b][1][0]), "+v"(acc[a][b][1][1]), "+v"(acc[a][b][2][0]), "+v"(acc[a][b][2][1]), "+v"(acc[a][b][3][0]), "+v"(acc[a][b][3][1])
            asm volatile("s_nop 15\n\ts_nop 7" : PG8_A4(0, 0), PG8_A4(0, 1));
            asm volatile("" : PG8_A4(1, 0), PG8_A4(1, 1));
#undef PG8_A4
        }
        if constexpr (!Epi::AFTER_DRAIN) { E(acc, cur, wr, wc, fr, fq, pf, est);
#ifdef EPI_TWICE_GLU
            if constexpr (is_glu<Epi>::v) { asm volatile("" ::: "memory"); if constexpr (EPI_TWICE_GLU == 2) E.probe_math(acc, pf); else E(acc, cur, wr, wc, fr, fq, pf, est); }
#endif
#ifdef EPI_TWICE
            if constexpr (Epi::IDEM) { asm volatile("" ::: "memory"); E(acc, cur, wr, wc, fr, fq, pf, est); }
#endif
            if constexpr (Sched::PUBD) pend_pm = cur.pm; else S.done(cur); }
#ifdef EPI_SLEEP
        if constexpr (Epi::IDEM) __builtin_amdgcn_s_sleep(EPI_SLEEP);
#endif
        if (!has_next) break;
#pragma unroll
        for (int a = 0; a < 2; ++a)
#pragma unroll
            for (int b = 0; b < 2; ++b)
#pragma unroll
                for (int m = 0; m < 4; ++m)
#pragma unroll
                    for (int n = 0; n < 2; ++n) { if constexpr (!ZERO_C) acc[a][b][m][n] = (f32x4){0.f, 0.f, 0.f, 0.f}; }
        cur = nxt; cA = nA; cB = nB; ++ui;
        if constexpr (ALIGN_EPI) { if (wr == 1) PG8_BAR; }
    }
    E.flush(est, wr, wc, fr, fq);
    asm volatile("s_waitcnt vmcnt(0)" ::: "memory"); if constexpr (Sched::PUBD) { if (pend_pm >= 0) S.publish(pend_pm); }
    if constexpr (!ALIGN_EPI) { if (wr == 0) PG8_BAR; }
    PG8_BAR;
    if constexpr (Epi::AFTER_DRAIN) { E.fused(acc, cur, wr, wc, fr, fq, lds, wid, lane); S.done(cur); }
#undef PG8_SA
#undef PG8_SB
#undef PG8_STAGE
#undef PG8_LD16
#undef PG8_LDA
#undef PG8_LDB
#undef PG8_MMA
#undef PG8_MMAZ
#undef PG8_WAIT_V
#undef PG8_WAIT_L
#undef PG8_BAR
#undef PG8_SCHED
#undef PG8_RPRIO
}
}

constexpr int NWAVES = 8;
#ifndef MK_PER_PHASE
#define MK_PER_PHASE 0
#endif
#ifndef MOE_FP8
#define MOE_FP8 1
#endif
#ifndef FFN2_FP8
#define FFN2_FP8 1
#endif
#ifndef FILL_TAILS
#define FILL_TAILS 1
#endif
#ifndef EPI_ALIGN_HEAVY
#define EPI_ALIGN_HEAVY true
#endif
#ifndef F8_SP2
#define F8_SP2 true
#endif
#ifndef WGM_E1
#define WGM_E1 2
#endif
#ifndef WGM_E4
#define WGM_E4 2
#endif
#ifndef WGM_O1
#define WGM_O1 2
#endif
#ifndef WGM_O6
#define WGM_O6 2
#endif
#ifndef WGM_O7
#define WGM_O7 2
#endif
#ifndef WGM_N4
#define WGM_N4 8
#endif
#ifndef MOE_CHAIN
#define MOE_CHAIN 0
#endif
#ifndef STAGGER
#define STAGGER 0
#endif
#ifndef MOE_OG8
#define MOE_OG8 (MOE_FP8)
#endif
#ifndef XCD_STAGGER
#define XCD_STAGGER 0
#endif
#ifndef FILL_N_E4
#define FILL_N_E4 5
#endif
#ifndef FILL_N_O7
#define FILL_N_O7 6
#endif
#ifndef DOWN8_L0
#define DOWN8_L0 1
#endif
#ifndef MIX8_L3
#define MIX8_L3 1
#endif
#ifndef MIX8IN_L2
#define MIX8IN_L2 1
#endif
#ifndef MIX8OUT_L2
#define MIX8OUT_L2 0
#endif
#ifndef GLU_WT
#define GLU_WT 0
#endif
#ifndef MK_LAST_PHASE
#define MK_LAST_PHASE 26
#endif

constexpr int M = 16384, D = 1024, SEQ = 8192, DFF = 2816, NE = 8, NFF2 = 2 * DFF;
constexpr int EV_IN = 2048, OD_IN = 3072, AW = 512, BW = 512, CHUNK = 128, KB = 31;
constexpr int MAXP = 136, MSLOT = MAXP * 256;
constexpr float LN_EPS = 1e-5f;
constexpr int NPHASE = 27;

constexpr size_t MiB = 1u << 20;
constexpr size_t WS_CTL = 0, CTL_ZERO_BYTES = 128 * 1024;
constexpr size_t WS_MISC = 2 * MiB;
constexpr size_t MI_RT = 0, MI_WSB = 64 * 1024, MI_TOKE = 512 * 1024, MI_TOKG = 640 * 1024, MI_TOKR = 768 * 1024, MI_TOKS = 896 * 1024,
                 MI_CNT = 1024 * 1024, MI_LNA = 2048 * 1024  , MI_TOKRS = 1472 * 1024, MI_HDR = 1040 * 1024, MI_RSG = 1088 * 1024, MI_GTG = 1280 * 1024;
constexpr size_t WS_SSQ = 6 * MiB;
constexpr size_t WS_WEV = 14 * MiB, EV_BYTES = 23 * MiB;
constexpr size_t EVO_WIN = 0, EVO_WOUT = 4 * MiB, EVO_W13 = 6 * MiB, EVO_W2 = 17 * MiB;
constexpr size_t WS_WOD = WS_WEV + 2 * EV_BYTES, OD_BYTES = 140 * MiB;
constexpr size_t ODO_WIN = 0, ODO_WOUT = 6 * MiB, ODO_W13 = 8 * MiB, ODO_W2 = 96 * MiB;
constexpr size_t WS_XB = WS_WOD + 2 * OD_BYTES;
constexpr size_t WS_R1 = WS_XB + 32 * MiB;
constexpr size_t WS_R2 = WS_R1 + 68 * MiB;
constexpr size_t WS_R3 = WS_R2 + 68 * MiB;
constexpr size_t WS_END = WS_R3 + 187 * MiB;
static_assert((size_t)MSLOT * D * 2 <= 68 * MiB && (size_t)MSLOT * DFF * 2 <= 187 * MiB && (size_t)M * DFF * 2 <= 187 * MiB, "d_ws map");
constexpr int CW_TMO = 0, CW_CODE = 1;
constexpr int CW_FILL = 2048;
constexpr int CW_PCNT = 8192, PCNT_WORDS = 136 * 64;
constexpr int CW_BAR = 4096;

constexpr int RING_BYTES = 131072;
constexpr int LDS_BYTES = 147456;
constexpr int STG_OFF = RING_BYTES;
constexpr int RED_OFF = RING_BYTES;
constexpr int PTAB_OFF = LDS_BYTES - 2048;
constexpr int MISC_OFF = LDS_BYTES - 512;

#define GAS __attribute__((address_space(1)))
#define LAS __attribute__((address_space(3)))
typedef unsigned short bf16;
typedef unsigned v4u __attribute__((ext_vector_type(4)));
typedef unsigned v2u __attribute__((ext_vector_type(2)));
typedef float f32x4 __attribute__((ext_vector_type(4)));
typedef float f32x2 __attribute__((ext_vector_type(2)));
typedef short bf16x8 __attribute__((ext_vector_type(8)));
typedef GAS unsigned gu32;
#define RLX_AGENT __ATOMIC_RELAXED, __HIP_MEMORY_SCOPE_AGENT
#define LDS_WAIT() asm volatile("s_waitcnt lgkmcnt(0)" ::: "memory")
#define VM_WAIT() asm volatile("s_waitcnt vmcnt(0)" ::: "memory")
using pg8::cvt_pk_bf16; using pg8::bf_lo; using pg8::bf_hi; using pg8::sigmoidf_fast; using pg8::siluf_fast; using pg8::RMS_EPS;

#define XB_TMO      128
#define XB_XCNT(j)  (256  + 64 * (j))
#define XB_XSUB(j)  (1280 + 64 * (j))
#define XB_XGEN(j)  (2304 + 64 * (j))
#define XB_TOP      3328
#define XB_TOPGEN   3392
#define XCD_BAR_WORDS 3456
#define XB_SPIN_CAP (1u << 18)
#define XB_LSUB(j)  (3456 + 16 * (j))
#define XB_LGEN(j)  (3712 + 16 * (j))
#define XB_MISM     3968
#ifndef LOCAL_BAR
#define LOCAL_BAR 1
#endif

__device__ __forceinline__ unsigned xb_ld(unsigned* p)              { return __hip_atomic_load(p, __ATOMIC_RELAXED, __HIP_MEMORY_SCOPE_AGENT); }
__device__ __forceinline__ unsigned xb_add(unsigned* p, unsigned v) { return __hip_atomic_fetch_add(p, v, __ATOMIC_RELAXED, __HIP_MEMORY_SCOPE_AGENT); }
__device__ __forceinline__ unsigned xb_xcc_id() { return (unsigned)__builtin_amdgcn_s_getreg((3 << 11) | 20) & 0xFu; }
#define XB_SPIN(cond, bar) do { unsigned _sp = 0; while (cond) { __builtin_amdgcn_s_sleep(1); \
    if ((++_sp & 255u) == 0u) { if (xb_ld(&(bar)[XB_TMO])) break; if (_sp > XB_SPIN_CAP) { atomicAdd(&(bar)[XB_TMO], 1u); break; } } } } while (0)

struct XcdBarrier {
    unsigned* bar; unsigned x;
    volatile LAS unsigned* st;
};

__device__ __forceinline__ XcdBarrier xcd_barrier_post(unsigned* bar, volatile LAS unsigned* st) {
    XcdBarrier b; b.bar = bar; b.x = xb_xcc_id(); b.st = st;
    if (threadIdx.x == 0) { (void)xb_add(&bar[XB_XCNT(b.x)], 1u); if (b.x != (blockIdx.x & 7u)) (void)xb_add(&bar[XB_MISM], 1u); }
    return b;
}
__device__ __forceinline__ void xcd_barrier_complete(unsigned* bar, unsigned x, unsigned& nloc, unsigned& nx, unsigned& even) {
    const unsigned G = gridDim.x * gridDim.y * gridDim.z;
    unsigned sum, cnt, mine, sp = 0u, ev;
    for (;;) {
        sum = 0u; cnt = 0u; mine = 0u; ev = 1u;
#pragma unroll
        for (unsigned j = 0; j < 16; ++j) { const unsigned c = xb_ld(&bar[XB_XCNT(j)]); sum += c; cnt += (c > 0u) ? 1u : 0u; mine = (j == x) ? c : mine; ev = (c > 0u && c * 8u != G) ? 0u : ev; }
        if (sum == G) break;
        __builtin_amdgcn_s_sleep(1);
        if ((++sp & 255u) == 0u) { if (xb_ld(&bar[XB_TMO])) break; if (sp > XB_SPIN_CAP) { atomicAdd(&bar[XB_TMO], 1u); break; } }
    }
    nloc = mine > 0u ? mine : 1u; nx = cnt > 0u ? cnt : 1u; even = (sum == G) ? ev : 0u;
}

__device__ __forceinline__ void xcd_barrier(const XcdBarrier& b) {
    asm volatile("s_waitcnt vmcnt(0)" ::: "memory");
    __syncthreads();
    if (threadIdx.x == 0) {
        unsigned* bar = b.bar;
        __builtin_amdgcn_s_waitcnt(0);
        unsigned nloc = b.st[0], nx = b.st[1];
        const bool first_ = (nloc == 0u);
        unsigned even_ = 0u;
        if (nloc == 0u) { xcd_barrier_complete(bar, b.x, nloc, nx, even_); b.st[0] = nloc; b.st[1] = nx; }
        const unsigned old = xb_add(&bar[XB_XSUB(b.x)], 1u);
        const unsigned gen = old / nloc;
        if (old + 1u == (gen + 1u) * nloc) {
            __builtin_amdgcn_fence(__ATOMIC_RELEASE, "agent");
            asm volatile("s_waitcnt vmcnt(0)" ::: "memory");
            const unsigned og = xb_add(&bar[XB_TOP], 1u);
            const unsigned tg = og / nx;
            if (og + 1u == (tg + 1u) * nx) xb_add(&bar[XB_TOPGEN], 1u);
            else XB_SPIN(xb_ld(&bar[XB_TOPGEN]) == tg, bar);
            __builtin_amdgcn_fence(__ATOMIC_ACQUIRE, "agent");
            xb_add(&bar[XB_XGEN(b.x)], 1u);
            asm volatile("s_waitcnt vmcnt(0)" ::: "memory");
        } else {
            XB_SPIN(xb_ld(&bar[XB_XGEN(b.x)]) == gen, bar);
            __builtin_amdgcn_fence(__ATOMIC_ACQUIRE, "agent");
            asm volatile("s_waitcnt vmcnt(0)" ::: "memory");
        }
        if (first_) {
            const unsigned G_ = gridDim.x; b.st[2] = (LOCAL_BAR != 0 && even_ != 0u && nx == 8u && G_ == 256u && xb_ld(&bar[XB_MISM]) == 0u) ? 1u : 0u; }
    }
    __syncthreads();
}
__device__ __forceinline__ void xcd_local_barrier(const XcdBarrier& b) {
    asm volatile("s_waitcnt vmcnt(0)" ::: "memory");
    __syncthreads();
    if (threadIdx.x == 0) {
        unsigned* bar = b.bar;
        __builtin_amdgcn_s_waitcnt(0);
        const unsigned nloc = b.st[0];
        const unsigned old = xb_add(&bar[XB_LSUB(b.x)], 1u);
        const unsigned gen = old / nloc;
        if (old + 1u == (gen + 1u) * nloc) xb_add(&bar[XB_LGEN(b.x)], 1u);
        else XB_SPIN(xb_ld(&bar[XB_LGEN(b.x)]) == gen, bar);
        __builtin_amdgcn_fence(__ATOMIC_ACQUIRE, "agent");
        asm volatile("s_waitcnt vmcnt(0)" ::: "memory");
    }
    __syncthreads();
}

typedef const float* fptr_t;
typedef __attribute__((address_space(4))) const fptr_t* intab_t;
struct Frame {
    LAS unsigned char* lds;
    volatile LAS unsigned* MISC;
    GAS unsigned char* ws;
    int tid, lane, wave;
    int vcu, G;
    intab_t in;
};
__device__ __forceinline__ float wave_sum(float v) { return pg8::wave_sum_valu(v); }
template <int N, int SZ, int OFF> __device__ __forceinline__ void reduce_scatter_step(float (&v)[SZ], int lane) {
#pragma unroll
    for (int i = 0; i < N / 2; ++i) { const bool hi = (lane & OFF) != 0; const float keep = hi ? v[i + N / 2] : v[i], send = hi ? v[i] : v[i + N / 2]; v[i] = keep + pg8::xor_get<OFF>(send, lane); }
}
__device__ __forceinline__ int opaque_v(int x) { asm volatile("" : "+v"(x)); return x; }
__device__ __forceinline__ int opaque_s(int x) { asm volatile("" : "+s"(x)); return x; }
__device__ __forceinline__ intab_t opaque_tab(intab_t p) { asm volatile("" : "+s"(p)); return p; }
__device__ __forceinline__ bf16* ev_w(Frame& F, int lp, size_t off) { return (bf16*)(F.ws + WS_WEV + (size_t)lp * EV_BYTES + off); }
__device__ __forceinline__ bf16* od_w(Frame& F, int lp, size_t off) { return (bf16*)(F.ws + WS_WOD + (size_t)lp * OD_BYTES + off); }
__device__ __forceinline__ bf16* ev_wl(GAS unsigned char* ws, int lp, size_t off) { return (bf16*)(ws + WS_WEV + (size_t)lp * EV_BYTES + off); }
__device__ __forceinline__ bf16* od_wl(GAS unsigned char* ws, int lp, size_t off) { return (bf16*)(ws + WS_WOD + (size_t)lp * OD_BYTES + off); }
__device__ __forceinline__ float* ssq_arr(Frame& F, int s) { return (float*)(F.ws + WS_SSQ) + (size_t)s * 4 * M; }
__device__ __forceinline__ float rstd_wave(const float* part, int row, int lane) { float s = (lane < 4) ? part[(size_t)lane * M + row] : 0.f; s = wave_sum(s); return __builtin_amdgcn_rsqf(s * (1.0f / 1024.0f) + RMS_EPS); }
__device__ __forceinline__ void ssq_store_row(float* part, int row, int lane, float s) { if (lane < 4) part[(size_t)lane * M + row] = (lane == 0) ? s : 0.f; }

__device__ __forceinline__ int p0_drow(int mode, int which, int n0) {
    if (mode == 0) return n0;
    if (mode == 1) return (n0 >> 7) * 256 + which * 128 + (n0 & 127);
    if (n0 < 1024) return n0;
    const int m = n0 - 1024, half = (mode == 2) ? 512 : 1024, w = m / half, mm = m % half;
    return 1024 + (mm >> 7) * 256 + w * 128 + (mm & 127);
}
struct P0Item { const float* src; const float* gsrc; bf16* dst; int N; int f8; };
constexpr int P0_I_EV = 5760, P0_I_OD = 35840, P0_I_PAIR = P0_I_EV + P0_I_OD, P0_NITEMS = 2 * P0_I_PAIR;
__device__ __forceinline__ P0Item p0_decode(Frame& F, int it, int lane) {
    const int lp = it / P0_I_PAIR; int r = it % P0_I_PAIR;
    const float* W; const float* gain = nullptr; bf16* WT; int K = 1024, N, mode = 0, which = 0, f8 = 0;
    if (r < P0_I_EV) {
        if (r < 1024)      { f8 = (MIX8IN_L2 != 0 && lp == 1); W = F.in[3] + (size_t)lp * 1024 * 2048; N = 2048; gain = F.in[1] + (2 * lp) * 1024; WT = ev_w(F, lp, EVO_WIN); mode = 2; }
        else if (r < 1536) { f8 = (MIX8OUT_L2 != 0 && lp == 1); r -= 1024; W = F.in[12] + (size_t)lp * 1024 * 1024; N = 1024; WT = ev_w(F, lp, EVO_WOUT); }
        else if (r < 2944) { f8 = (FFN2_FP8 && lp == 1); r -= 1536; W = F.in[16] + (size_t)lp * 1024 * DFF; N = DFF; gain = F.in[2] + (2 * lp) * 1024; WT = ev_w(F, lp, EVO_W13); mode = 1; which = 0; }
        else if (r < 4352) { f8 = (FFN2_FP8 && lp == 1); r -= 2944; W = F.in[17] + (size_t)lp * 1024 * DFF; N = DFF; gain = F.in[2] + (2 * lp) * 1024; WT = ev_w(F, lp, EVO_W13); mode = 1; which = 1; }
        else               { f8 = (FFN2_FP8 && lp == 1) || (DOWN8_L0 != 0 && lp == 0); r -= 4352; W = F.in[18] + (size_t)lp * DFF * 1024; N = 1024; K = DFF; WT = ev_w(F, lp, EVO_W2); }
    } else {
        r -= P0_I_EV;
        if (r < 1536)      { f8 = (MIX8_L3 != 0 && lp == 1); W = F.in[13] + (size_t)lp * 1024 * 3072; N = 3072; gain = F.in[1] + (2 * lp + 1) * 1024; WT = od_w(F, lp, ODO_WIN); mode = 3; }
        else if (r < 2048) { f8 = (MIX8_L3 != 0 && lp == 1); r -= 1536; W = F.in[15] + (size_t)lp * 1024 * 1024; N = 1024; WT = od_w(F, lp, ODO_WOUT); }
        else { r -= 2048; const int e = r / 4224, q = r % 4224, t = q / 1408; r = q % 1408; const size_t le = (size_t)(lp * NE + e); f8 = MOE_FP8;
            if (t == 0)      { W = F.in[20] + le * 1024 * DFF; N = DFF; gain = F.in[2] + (2 * lp + 1) * 1024; WT = (bf16*)((unsigned char*)od_w(F, lp, ODO_W13) + (size_t)e * NFF2 * 1024 * (MOE_FP8 ? 1 : 2)); mode = 1; which = 0; }
            else if (t == 1) { W = F.in[21] + le * 1024 * DFF; N = DFF; gain = F.in[2] + (2 * lp + 1) * 1024; WT = (bf16*)((unsigned char*)od_w(F, lp, ODO_W13) + (size_t)e * NFF2 * 1024 * (MOE_FP8 ? 1 : 2)); mode = 1; which = 1; }
            else             { W = F.in[22] + le * DFF * 1024; N = 1024; K = DFF; WT = (bf16*)((unsigned char*)od_w(F, lp, ODO_W2) + (size_t)e * 1024 * DFF * (MOE_FP8 ? 1 : 2)); } }
    }
    const int nblk = N / 32, kb = r / nblk, nb = r % nblk, k0 = 64 * kb, n0 = 32 * nb;
    P0Item p; p.N = N; p.f8 = f8;
    p.src = W + (size_t)(k0 + (lane >> 3)) * N + n0 + 4 * (lane & 7);
    p.gsrc = gain ? gain + k0 + (lane >> 3) : nullptr;
    { const size_t eoff = (size_t)(p0_drow(mode, which, n0) + (lane >> 1)) * K + k0 + 32 * (lane & 1); p.dst = f8 ? (bf16*)((unsigned char*)WT + eoff) : WT + eoff; }
    return p;
}
__device__ __forceinline__ void p0_load(const P0Item& p, f32x4 (&v)[8], float (&g)[8]) {
#pragma unroll
    for (int i = 0; i < 8; ++i) { v[i] = __builtin_nontemporal_load((const GAS f32x4*)(p.src + (size_t)(8 * i) * p.N)); g[i] = p.gsrc ? p.gsrc[8 * i] : 1.0f; }
}
__device__ __forceinline__ void p0_store(const P0Item& p, const f32x4 (&v)[8], const float (&g)[8], LAS float* T, int lane) {
    const int r = lane >> 3, c4 = lane & 7;
#pragma unroll
    for (int i = 0; i < 8; ++i)
#pragma unroll
        for (int j = 0; j < 4; ++j) T[(4 * c4 + j) * 68 + 8 * i + r] = v[i][j] * g[i];
    LDS_WAIT(); asm volatile("" ::: "memory");
    const LAS f32x4* row = (const LAS f32x4*)(T + (lane >> 1) * 68 + 32 * (lane & 1));
    if (p.f8) {
#pragma unroll
        for (int q = 0; q < 2; ++q) { const pg8::u32x2 lo = pg8::pack8_fp8(row[4 * q] * pg8::W8_SCALE, row[4 * q + 1] * pg8::W8_SCALE), hi = pg8::pack8_fp8(row[4 * q + 2] * pg8::W8_SCALE, row[4 * q + 3] * pg8::W8_SCALE);
            v4u o; o.x = lo.x; o.y = lo.y; o.z = hi.x; o.w = hi.y; *(GAS v4u*)((unsigned char*)p.dst + 16 * q) = o; }
    } else {
#pragma unroll
    for (int q = 0; q < 4; ++q) { const f32x4 a = row[2 * q], b = row[2 * q + 1];
        v4u o; o.x = cvt_pk_bf16(a[0], a[1]); o.y = cvt_pk_bf16(a[2], a[3]); o.z = cvt_pk_bf16(b[0], b[1]); o.w = cvt_pk_bf16(b[2], b[3]);
        *(GAS v4u*)(p.dst + 8 * q) = o; }
    }
    LDS_WAIT(); asm volatile("" ::: "memory");
}
__device__ __forceinline__ void p0_convert_range(Frame& F, int first, int last, int start, int stride) {
    LAS float* T = (LAS float*)(F.lds + F.wave * 16384);
    int it = first + start; P0Item cur; f32x4 va[8]; float ga[8];
    if (it < last) { cur = p0_decode(F, it, F.lane); p0_load(cur, va, ga); }
#pragma unroll 1
    while (it < last) {
        const int nit = it + stride; P0Item nxt = cur; f32x4 vb[8]; float gb[8];
        if (nit < last) { nxt = p0_decode(F, nit, F.lane); p0_load(nxt, vb, gb); }
        p0_store(cur, va, ga, T, F.lane);
        if (nit < last) {
#pragma unroll
            for (int i = 0; i < 8; ++i) { va[i] = vb[i]; ga[i] = gb[i]; } }
        cur = nxt; it = nit;
    }
}
constexpr int FILL_CHUNK = 16, FILL_NCHUNK = P0_I_PAIR / FILL_CHUNK;
#ifndef BAR_FILL
#define BAR_FILL 0
#endif
constexpr int BF_SLOTS = 14, BF_WAVES = NWAVES - 1;
__device__ __forceinline__ int bf_nstat(int G) { const int n = (BF_SLOTS * G * BF_WAVES) & ~(FILL_CHUNK - 1); return (BAR_FILL && FILL_TAILS) ? (n < P0_I_PAIR ? n : P0_I_PAIR) : 0; }
static_assert(P0_I_PAIR % FILL_CHUNK == 0, "filler chunks");
__device__ __forceinline__ void fill_convert(Frame& F, int nmax) {
#if FILL_TAILS
#pragma unroll 1
    for (int c = 0; c < nmax; ++c) {
        if (F.tid == 0) F.MISC[16] = __hip_atomic_fetch_add((unsigned*)((gu32*)(F.ws + WS_CTL) + CW_FILL), 1u, __ATOMIC_RELAXED, __HIP_MEMORY_SCOPE_AGENT);
        __syncthreads();
        const unsigned ch = F.MISC[16];
        __syncthreads();
        const int nstat = bf_nstat(F.G);
        if (ch >= (unsigned)((P0_I_PAIR - nstat) / FILL_CHUNK)) break;
        p0_convert_range(F, P0_I_PAIR + nstat + (int)ch * FILL_CHUNK, P0_I_PAIR + nstat + (int)ch * FILL_CHUNK + FILL_CHUNK, F.wave, NWAVES);
    }
#endif
}
__device__ __forceinline__ void half_unit_wait(int ticks) { const unsigned long long t0 = __builtin_amdgcn_s_memrealtime(); while (__builtin_amdgcn_s_memrealtime() - t0 < (unsigned long long)ticks) __builtin_amdgcn_s_sleep(32); }
__device__ __forceinline__ void stagger_wait(int c, int unit_ticks) {
#if STAGGER
    const unsigned long long t0 = __builtin_amdgcn_s_memrealtime(); const unsigned long long d = (unsigned long long)(((unsigned)c * 37u) & 15u) * (unsigned)unit_ticks / 16u;
    while (__builtin_amdgcn_s_memrealtime() - t0 < d) __builtin_amdgcn_s_sleep(32);
#endif
}
__device__ __forceinline__ bool fill_idle(int nwg, int G, int c) { const int mine = (nwg > c) ? (nwg - c + G - 1) / G : 0; return mine < (nwg + G - 1) / G; }
#if !MK_PER_PHASE
__device__ __forceinline__ void xcd_barrier_fill(const XcdBarrier& b, Frame& F, int slot) {
    asm volatile("s_waitcnt vmcnt(0)" ::: "memory");
    __syncthreads();
    const int wave = opaque_s(F.wave);
    if (wave == 0) {
      if (threadIdx.x == 0) {
        unsigned* bar = b.bar;
        __builtin_amdgcn_s_waitcnt(0);
        unsigned nloc = b.st[0], nx = b.st[1];
        if (nloc == 0u) { unsigned ev_ = 0u; xcd_barrier_complete(bar, b.x, nloc, nx, ev_); b.st[0] = nloc; b.st[1] = nx; }
        const unsigned old = xb_add(&bar[XB_XSUB(b.x)], 1u);
        const unsigned gen = old / nloc;
        if (old + 1u == (gen + 1u) * nloc) {
            __builtin_amdgcn_fence(__ATOMIC_RELEASE, "agent");
            asm volatile("s_waitcnt vmcnt(0)" ::: "memory");
            const unsigned og = xb_add(&bar[XB_TOP], 1u);
            const unsigned tg = og / nx;
            if (og + 1u == (tg + 1u) * nx) xb_add(&bar[XB_TOPGEN], 1u);
            else XB_SPIN(xb_ld(&bar[XB_TOPGEN]) == tg, bar);
            __builtin_amdgcn_fence(__ATOMIC_ACQUIRE, "agent");
            xb_add(&bar[XB_XGEN(b.x)], 1u);
            asm volatile("s_waitcnt vmcnt(0)" ::: "memory");
        } else {
            XB_SPIN(xb_ld(&bar[XB_XGEN(b.x)]) == gen, bar);
            __builtin_amdgcn_fence(__ATOMIC_ACQUIRE, "agent");
            asm volatile("s_waitcnt vmcnt(0)" ::: "memory");
        }
      }
    } else {
        const int idx = (slot * F.G + F.vcu) * BF_WAVES + wave - 1;
        if (idx < bf_nstat(F.G)) {
            const int lane = opaque_v(F.tid) & 63;
            LAS float* T = (LAS float*)(F.lds + wave * 16384);
            const P0Item it = p0_decode(F, P0_I_PAIR + idx, lane); f32x4 v[8]; float g[8];
            p0_load(it, v, g); p0_store(it, v, g, T, lane);
        }
    }
    __syncthreads();
}
#endif
__device__ __forceinline__ void p0_prologue(Frame& F) {
    const int gw = F.vcu * NWAVES + F.wave, NGW = F.G * NWAVES;
    p0_convert_range(F, 0, FILL_TAILS ? P0_I_PAIR : P0_NITEMS, gw, NGW);
    { bf16* xb = (bf16*)(F.ws + WS_XB); float* ssq0 = ssq_arr(F, 0);
      for (int m = gw; m < M; m += NGW) { const GAS f32x4* xr = (const GAS f32x4*)(F.in[0] + (size_t)m * D) + F.lane; f32x4 v[4]; float s = 0.f;
#pragma unroll
          for (int j = 0; j < 4; ++j) { v[j] = __builtin_nontemporal_load(xr + 64 * j); s += (v[j].x * v[j].x + v[j].y * v[j].y) + (v[j].z * v[j].z + v[j].w * v[j].w); }
          s = wave_sum(s);
          GAS v2u* o8 = (GAS v2u*)(xb + (size_t)m * D) + F.lane;
#pragma unroll
          for (int j = 0; j < 4; ++j) { v2u w; w.x = cvt_pk_bf16(v[j].x, v[j].y); w.y = cvt_pk_bf16(v[j].z, v[j].w); o8[64 * j] = w; }
          ssq_store_row(ssq0, m, F.lane, s); } }
    { float* Rt = (float*)(F.ws + WS_MISC + MI_RT); bf16* WsB = (bf16*)(F.ws + WS_MISC + MI_WSB);
      const int gt = F.vcu * NWAVES * 64 + F.tid, NGT = F.G * NWAVES * 64;
      for (int i = gt; i < 2 * NE * 1024; i += NGT) { const int lp = i / (NE * 1024), e = (i / 1024) % NE, k = i % 1024; Rt[i] = F.in[19][((size_t)lp * 1024 + k) * NE + e] * F.in[2][(2 * lp + 1) * 1024 + k]; }
      for (int i = gt; i < 2 * 4 * 128 * 128 / 2; i += NGT) { const float a = F.in[4][2 * i], b = F.in[4][2 * i + 1]; ((unsigned*)WsB)[i] = cvt_pk_bf16(a, b); } }
}

struct MixBTile { v4u v[12]; };
__device__ __forceinline__ void mix_b_request(Frame& F, int hc, int tid, MixBTile& T) {
    const bf16* glu = (const bf16*)(F.ws + WS_R1 + 32 * MiB); const int R0 = hc * 64, p0 = R0 % SEQ;
#pragma unroll
    for (int i = 0; i < 12; ++i) { const int idx = tid + i * NWAVES * 64, r = idx >> 6, c16 = idx & 63, pos = p0 - 15 + r;
        T.v[i] = (v4u){0u, 0u, 0u, 0u}; if (idx < 94 * 64 && pos >= 0 && pos < SEQ) T.v[i] = *(const GAS v4u*)(glu + (size_t)(R0 - 15 + r) * BW + 8 * c16); }
}
constexpr int VN_STRIDE = 520;
__device__ __forceinline__ void mix_unit_a(Frame& F, int lp, int chunk, int hp, int hc, MixBTile& BT, int& tid_out) {
    const bf16* za = (const bf16*)(F.ws + WS_R1); bf16* mix = (bf16*)(F.ws + WS_R2); const f32x2* lna = (const f32x2*)(F.ws + WS_MISC + MI_LNA);
    const int R0 = chunk * CHUNK, w = F.wave, l = opaque_v(F.lane), tid = 64 * w + l; tid_out = tid;
    LAS f32x2* stat = (LAS f32x2*)(F.lds + 128 * VN_STRIDE);
    v4u raw[8];
    { const bf16* src = za + (size_t)(R0 + 16 * w + (l >> 5)) * 1024 + 512 + 256 * hp + 8 * (l & 31);
#pragma unroll
      for (int i = 0; i < 8; ++i) raw[i] = *(const GAS v4u*)(src + (size_t)(2 * i) * 1024); }
    const int h = 2 * hp + (w >> 2), tq = w & 3, li = l & 15, g = l >> 4;
    LAS unsigned char* AU = F.lds + 128 * VN_STRIDE + 1024;
    { v4u aur[8];
#pragma unroll
      for (int i = 0; i < 8; ++i) { const int idx = tid + 512 * i, row = idx >> 5, c = idx & 31; aur[i] = *(const GAS v4u*)(za + (size_t)(R0 + row) * 1024 + 256 * hp + 8 * c); }
#pragma unroll
      for (int i = 0; i < 8; ++i) { const int idx = tid + 512 * i, row = idx >> 5, c = idx & 31; *(LAS v4u*)(AU + row * 528 + 16 * c) = aur[i]; } }
    const bf16* WsB = (const bf16*)(F.ws + WS_MISC + MI_WSB) + (size_t)(lp * 4 + h) * 128 * 128;
    bf16x8 Y[2][4];
#pragma unroll
    for (int mt = 0; mt < 2; ++mt)
#pragma unroll
        for (int kk = 0; kk < 4; ++kk) Y[mt][kk] = *(const GAS bf16x8*)(WsB + (size_t)(32 * tq + 16 * mt + li) * 128 + 32 * kk + 8 * g);
    if (tid < 128) { float s = 0.f, q = 0.f;
#pragma unroll
        for (int p = 0; p < 8; ++p) { const f32x2 v = lna[(size_t)p * M + R0 + tid]; s += v.x; q += v.y; }
        const float mean = s * (1.0f / AW), var = fmaxf(q * (1.0f / AW) - mean * mean, 0.f); stat[tid] = (f32x2){mean, __builtin_amdgcn_rsqf(var + LN_EPS)}; }
    const int c0 = 256 * hp + 8 * (l & 31);
    const f32x4 g0 = *(const GAS f32x4*)(F.in[6] + lp * AW + c0), g1 = *(const GAS f32x4*)(F.in[6] + lp * AW + c0 + 4);
    const f32x4 b0 = *(const GAS f32x4*)(F.in[7] + lp * AW + c0), b1 = *(const GAS f32x4*)(F.in[7] + lp * AW + c0 + 4);
    __syncthreads();
#pragma unroll
    for (int i = 0; i < 8; ++i) { const int row = 16 * w + (l >> 5) + 2 * i; const f32x2 st = stat[row];
        f32x4 v0, v1; v0[0] = bf_lo(raw[i].x); v0[1] = bf_hi(raw[i].x); v0[2] = bf_lo(raw[i].y); v0[3] = bf_hi(raw[i].y); v1[0] = bf_lo(raw[i].z); v1[1] = bf_hi(raw[i].z); v1[2] = bf_lo(raw[i].w); v1[3] = bf_hi(raw[i].w);
        v0 = (v0 - st.x) * st.y * g0 + b0; v1 = (v1 - st.x) * st.y * g1 + b1;
        LAS v2u* dst = (LAS v2u*)(F.lds + row * VN_STRIDE + 16 * (l & 31));
        v2u p0, p1; p0.x = cvt_pk_bf16(v0[0], v0[1]); p0.y = cvt_pk_bf16(v0[2], v0[3]); p1.x = cvt_pk_bf16(v1[0], v1[1]); p1.y = cvt_pk_bf16(v1[2], v1[3]);
        dst[0] = p0; dst[1] = p1; }
    __syncthreads();
    mix_b_request(F, hc, tid, BT);
    {
        const float* bs = F.in[5] + (lp * 4 + h) * 128;
#pragma unroll
        for (int nt = 0; nt < 8; ++nt) {
            f32x4 acc[2];
#pragma unroll
            for (int mt = 0; mt < 2; ++mt) acc[mt] = (f32x4){0.f, 0.f, 0.f, 0.f};
#pragma unroll
            for (int kk = 0; kk < 4; ++kk) {
                const LAS unsigned short* xp = (const LAS unsigned short*)(F.lds + (32 * kk + 8 * g) * VN_STRIDE + 2 * (128 * (w >> 2) + 16 * nt + li));
                bf16x8 X;
#pragma unroll
                for (int j = 0; j < 8; ++j) X[j] = (short)xp[j * (VN_STRIDE / 2)];
#pragma unroll
                for (int mt = 0; mt < 2; ++mt) acc[mt] = __builtin_amdgcn_mfma_f32_16x16x32_bf16(X, Y[mt][kk], acc[mt], 0, 0, 0);
            }
#pragma unroll
            for (int mt = 0; mt < 2; ++mt) { const int t = 32 * tq + 16 * mt + li, d0 = 16 * nt + 4 * g; const float bias = bs[t];
                const size_t off = (size_t)(R0 + t) * 1024 + 128 * h + d0;
                LAS v2u* aup = (LAS v2u*)(AU + t * 528 + 2 * (128 * (w >> 2) + d0)); const v2u au = *aup;
                v2u o; o.x = cvt_pk_bf16(bf_lo(au.x) * (acc[mt][0] + bias), bf_hi(au.x) * (acc[mt][1] + bias)); o.y = cvt_pk_bf16(bf_lo(au.y) * (acc[mt][2] + bias), bf_hi(au.y) * (acc[mt][3] + bias));
                *aup = o; }
        }
    }
    __syncthreads();
#pragma unroll
    for (int i = 0; i < 8; ++i) { const int idx = tid + 512 * i, row = idx >> 5, c = idx & 31; const v4u av = *(const LAS v4u*)(AU + row * 528 + 16 * c);
        if ((MIX8OUT_L2 != 0) && lp == 1) { int lo = 0, hi = 0; lo = __builtin_amdgcn_cvt_pk_fp8_f32(bf_lo(av.x), bf_hi(av.x), lo, false); lo = __builtin_amdgcn_cvt_pk_fp8_f32(bf_lo(av.y), bf_hi(av.y), lo, true);
            hi = __builtin_amdgcn_cvt_pk_fp8_f32(bf_lo(av.z), bf_hi(av.z), hi, false); hi = __builtin_amdgcn_cvt_pk_fp8_f32(bf_lo(av.w), bf_hi(av.w), hi, true);
            v2u o8; o8.x = (unsigned)lo; o8.y = (unsigned)hi; *(GAS v2u*)((GAS unsigned char*)mix + (size_t)(R0 + row) * 1024 + 256 * hp + 8 * c) = o8; }
        else *(GAS v4u*)(mix + (size_t)(R0 + row) * 1024 + 256 * hp + 8 * c) = av; }
    __syncthreads();
}
__device__ __forceinline__ void mix_unit_b(Frame& F, int lp, int hc, int tid, const MixBTile& T) {
    bf16* mix = (bf16*)(F.ws + WS_R2);
    const int R0 = hc * 64, lane = tid & 63;
#pragma unroll
    for (int i = 0; i < 12; ++i) { const int idx = tid + i * NWAVES * 64, r = idx >> 6, c16 = idx & 63; if (idx < 94 * 64) *(LAS v4u*)(F.lds + r * 1024 + 16 * c16) = T.v[i]; }
    const int cp = tid & 255, grp = tid >> 8, wg4 = F.wave & 3;
    f32x2 wt[KB];
#pragma unroll
    for (int j = 0; j < KB; ++j) wt[j] = *(const GAS f32x2*)(F.in[8] + ((size_t)lp * KB + j) * BW + 2 * cp);
    const f32x2 cb = *(const GAS f32x2*)(F.in[9] + lp * BW + 2 * cp), lg = *(const GAS f32x2*)(F.in[10] + lp * BW + 2 * cp), lb = *(const GAS f32x2*)(F.in[11] + lp * BW + 2 * cp);
    LAS float* red = (LAS float*)(F.lds + 98304);
    LAS float* st = (LAS float*)(F.lds + 98304 + 1024);
    __syncthreads();
#pragma unroll 1
    for (int run = 0; run < 2; ++run) {
        const int o0 = 32 * grp + 16 * run;
        f32x2 acc[16];
#pragma unroll
        for (int o = 0; o < 16; ++o) acc[o] = cb;
        unsigned xc[4], xn[4];
#pragma unroll
        for (int i = 0; i < 4; ++i) xc[i] = *(const LAS unsigned*)(F.lds + (o0 + i) * 1024 + 4 * cp);
#pragma unroll
        for (int rb = 0; rb < 48; rb += 4) {
#pragma unroll
            for (int i = 0; i < 4; ++i) { xn[i] = 0u; if (rb + 4 + i < 46) xn[i] = *(const LAS unsigned*)(F.lds + (o0 + rb + 4 + i) * 1024 + 4 * cp); }
#pragma unroll
            for (int i = 0; i < 4; ++i) { const int r = rb + i; if (r < 46) { const f32x2 x = (f32x2){bf_lo(xc[i]), bf_hi(xc[i])};
#pragma unroll
                for (int o = 0; o < 16; ++o) { if (r - o >= 0 && r - o < KB) acc[o] = __builtin_elementwise_fma(wt[r - o], x, acc[o]); } } }
            __builtin_amdgcn_sched_barrier(0);
#pragma unroll
            for (int i = 0; i < 4; ++i) xc[i] = xn[i]; }
        { float v[32];
#pragma unroll
          for (int o = 0; o < 16; ++o) { v[o] = acc[o].x + acc[o].y; v[16 + o] = acc[o].x * acc[o].x + acc[o].y * acc[o].y; }
          reduce_scatter_step<32, 32, 32>(v, lane); reduce_scatter_step<16, 32, 16>(v, lane); reduce_scatter_step<8, 32, 8>(v, lane); reduce_scatter_step<4, 32, 4>(v, lane); reduce_scatter_step<2, 32, 2>(v, lane);
          const float tot = v[0] + pg8::xor_get<1>(v[0], lane);
          if ((lane & 1) == 0) red[(grp * 4 + wg4) * 32 + (lane >> 1)] = tot; }
        __syncthreads();
        if (tid < 32) { const int gg = tid >> 4, o = tid & 15; float s = 0.f, q = 0.f;
#pragma unroll
            for (int k = 0; k < 4; ++k) { s += red[(gg * 4 + k) * 32 + o]; q += red[(gg * 4 + k) * 32 + 16 + o]; }
            const float mean = s * (1.0f / BW), var = fmaxf(q * (1.0f / BW) - mean * mean, 0.f);
            st[(gg * 16 + o) * 2] = mean; st[(gg * 16 + o) * 2 + 1] = __builtin_amdgcn_rsqf(var + LN_EPS); }
        __syncthreads();
#pragma unroll
        for (int o = 0; o < 16; ++o) { const float mean = st[(grp * 16 + o) * 2], rstd = st[(grp * 16 + o) * 2 + 1];
            const float y0 = (acc[o].x - mean) * rstd * lg.x + lb.x, y1 = (acc[o].y - mean) * rstd * lg.y + lb.y;
            if ((MIX8OUT_L2 != 0) && lp == 1) { const int w8 = __builtin_amdgcn_cvt_pk_fp8_f32(siluf_fast(y0), siluf_fast(y1), 0, false); *(GAS unsigned short*)((GAS unsigned char*)mix + (size_t)(R0 + o0 + o) * 1024 + 512 + 2 * cp) = (unsigned short)w8; }
            else *(GAS unsigned*)(mix + (size_t)(R0 + o0 + o) * 1024 + 512 + 2 * cp) = cvt_pk_bf16(siluf_fast(y0), siluf_fast(y1)); }
    }
    __syncthreads();
}

__device__ __forceinline__ void conv3_phase(Frame& F, int lp) {
    const bf16* gb = (const bf16*)(F.ws + WS_R1); const bf16* cv = (const bf16*)(F.ws + WS_R1 + 32 * MiB); bf16* y = (bf16*)(F.ws + WS_R2);
    const int gw = F.vcu * NWAVES + F.wave, NGW = F.G * NWAVES; const bool y8 = (MIX8_L3 != 0) && lp == 1;
    for (int item = gw; item < 2 * (M / 16); item += NGW) {
        const int r0 = (item >> 1) * 16, ch0 = 512 * (item & 1) + 8 * F.lane, p = r0 % SEQ;
        f32x4 w[3][2];
#pragma unroll
        for (int j = 0; j < 3; ++j) { w[j][0] = *(const GAS f32x4*)(F.in[14] + ((size_t)lp * 3 + j) * 1024 + ch0); w[j][1] = *(const GAS f32x4*)(F.in[14] + ((size_t)lp * 3 + j) * 1024 + ch0 + 4); }
        v4u prev = (v4u){0u, 0u, 0u, 0u}; if (p > 0) prev = *(const GAS v4u*)(cv + (size_t)(r0 - 1) * 1024 + ch0);
        v4u cur = *(const GAS v4u*)(cv + (size_t)r0 * 1024 + ch0);
#pragma unroll 4
        for (int i = 0; i < 16; ++i) { const int row = r0 + i;
            v4u nxt = (v4u){0u, 0u, 0u, 0u}; if (p + i + 1 < SEQ) nxt = *(const GAS v4u*)(cv + (size_t)(row + 1) * 1024 + ch0);
            const v4u g = *(const GAS v4u*)(gb + (size_t)row * 1024 + ch0);
            v4u o; float f[8];
#pragma unroll
            for (int k = 0; k < 4; ++k) { const int a = (2 * k) & 3, b = (2 * k + 1) & 3, hh = k >> 1;
                const float c0 = w[0][hh][a] * bf_lo(prev[k]) + w[1][hh][a] * bf_lo(cur[k]) + w[2][hh][a] * bf_lo(nxt[k]);
                const float c1 = w[0][hh][b] * bf_hi(prev[k]) + w[1][hh][b] * bf_hi(cur[k]) + w[2][hh][b] * bf_hi(nxt[k]);
                f[2 * k] = bf_lo(g[k]) * c0; f[2 * k + 1] = bf_hi(g[k]) * c1; o[k] = cvt_pk_bf16(f[2 * k], f[2 * k + 1]); }
            if (y8) { int lo = 0, hi = 0; lo = __builtin_amdgcn_cvt_pk_fp8_f32(f[0], f[1], lo, false); lo = __builtin_amdgcn_cvt_pk_fp8_f32(f[2], f[3], lo, true); hi = __builtin_amdgcn_cvt_pk_fp8_f32(f[4], f[5], hi, false); hi = __builtin_amdgcn_cvt_pk_fp8_f32(f[6], f[7], hi, true);
                v2u o8; o8.x = (unsigned)lo; o8.y = (unsigned)hi; *(GAS v2u*)((GAS unsigned char*)y + (size_t)row * 1024 + ch0) = o8; }
            else *(GAS v4u*)(y + (size_t)row * 1024 + ch0) = o;
            prev = cur; cur = nxt; }
    }
}

__device__ __forceinline__ void router_phase(Frame& F, int lp, const float* ssq) {
    const bf16* xb = (const bf16*)(F.ws + WS_XB); const float* Rt = (const float*)(F.ws + WS_MISC + MI_RT) + (size_t)lp * NE * 1024;
    int* tok_e = (int*)(F.ws + WS_MISC + MI_TOKE); float* tok_g = (float*)(F.ws + WS_MISC + MI_TOKG); int* tok_r = (int*)(F.ws + WS_MISC + MI_TOKR); int* cnt = (int*)(F.ws + WS_MISC + MI_CNT); float* tok_rs = (float*)(F.ws + WS_MISC + MI_TOKRS);
    LAS int* te = (LAS int*)(F.lds);
    LAS float* lgs = (LAS float*)(F.lds + 1024) + F.wave * 64;
    const int l = F.lane;
    for (int vb = opaque_s(F.vcu); vb < M / 64; vb += F.G) {
        const int t0 = 64 * vb + 8 * F.wave;
        float sA = (l < 32) ? ssq[(size_t)(l & 3) * M + t0 + (l >> 2)] : 0.f;
        float v[64];
        v4u xall[8], xcll[8];
#pragma unroll
        for (int j = 0; j < 8; ++j) { xall[j] = *(const GAS v4u*)(xb + (size_t)(t0 + j) * 1024 + 8 * l); xcll[j] = *(const GAS v4u*)(xb + (size_t)(t0 + j) * 1024 + 512 + 8 * l); }
#pragma unroll
        for (int hb = 0; hb < 2; ++hb) {
            v4u xa[4], xc[4];
#pragma unroll
            for (int j = 0; j < 4; ++j) { xa[j] = xall[4 * hb + j]; xc[j] = xcll[4 * hb + j]; }
#pragma unroll
            for (int e = 0; e < NE; ++e) { const f32x4 r0 = *(const GAS f32x4*)(Rt + e * 1024 + 8 * l), r1 = *(const GAS f32x4*)(Rt + e * 1024 + 8 * l + 4), r2 = *(const GAS f32x4*)(Rt + e * 1024 + 512 + 8 * l), r3 = *(const GAS f32x4*)(Rt + e * 1024 + 512 + 8 * l + 4);
#pragma unroll
                for (int j = 0; j < 4; ++j) { const v4u a = xa[j], b = xc[j];
                    f32x4 s = (f32x4){bf_lo(a.x), bf_hi(a.x), bf_lo(a.y), bf_hi(a.y)} * r0; s = s + (f32x4){bf_lo(a.z), bf_hi(a.z), bf_lo(a.w), bf_hi(a.w)} * r1;
                    s = s + (f32x4){bf_lo(b.x), bf_hi(b.x), bf_lo(b.y), bf_hi(b.y)} * r2; s = s + (f32x4){bf_lo(b.z), bf_hi(b.z), bf_lo(b.w), bf_hi(b.w)} * r3;
                    v[(4 * hb + j) * 8 + e] = (s[0] + s[1]) + (s[2] + s[3]); } }
            __builtin_amdgcn_sched_barrier(0);
        }
        reduce_scatter_step<64, 64, 32>(v, l); reduce_scatter_step<32, 64, 16>(v, l); reduce_scatter_step<16, 64, 8>(v, l); reduce_scatter_step<8, 64, 4>(v, l); reduce_scatter_step<4, 64, 2>(v, l); reduce_scatter_step<2, 64, 1>(v, l);
        lgs[l] = v[0];
        sA += pg8::xor_get<1>(sA, l); sA += pg8::xor_get<2>(sA, l);
        const int jt = l & 7;
        const float rs = __builtin_amdgcn_rsqf(__shfl(sA, 4 * jt) * (1.0f / 1024.0f) + RMS_EPS);
        LDS_WAIT(); asm volatile("" ::: "memory");
        if (l < 8) { float lg[NE];
#pragma unroll
            for (int e = 0; e < NE; ++e) lg[e] = lgs[l * 8 + e];
            int i0 = 0; float v0 = lg[0];
#pragma unroll
            for (int e = 1; e < NE; ++e) if (lg[e] > v0) { v0 = lg[e]; i0 = e; }
            int i1 = -1; float v1 = -3.0e38f;
#pragma unroll
            for (int e = 0; e < NE; ++e) if (e != i0 && lg[e] > v1) { v1 = lg[e]; i1 = e; }
            const float g0 = __builtin_amdgcn_rcpf(1.0f + __expf((v1 - v0) * rs)), g1 = 1.0f - g0;
            const int tl = 8 * F.wave + l, t = t0 + l;
            te[2 * tl] = i0; te[2 * tl + 1] = i1; tok_e[2 * t] = i0; tok_e[2 * t + 1] = i1; tok_g[2 * t] = g0; tok_g[2 * t + 1] = g1; tok_rs[t] = rs; }
        __syncthreads();
        if (F.wave == 0) { const int e0 = te[2 * l], e1 = te[2 * l + 1]; int r0 = 0, r1 = 0, mycnt = 0;
#pragma unroll
            for (int e = 0; e < NE; ++e) { const unsigned long long mk = __ballot(e0 == e || e1 == e); const int rk = __popcll(mk & ((1ull << l) - 1ull)), c = __popcll(mk);
                if (e0 == e) r0 = rk; if (e1 == e) r1 = rk; if (l == e) mycnt = c; }
            const int t = 64 * vb + l; tok_r[2 * t] = r0; tok_r[2 * t + 1] = r1; if (l < NE) cnt[vb * NE + l] = mycnt; }
        __syncthreads();
    }
}
__device__ __forceinline__ void gather_phase(Frame& F) {
    const bf16* xb = (const bf16*)(F.ws + WS_XB); bf16* xg = (bf16*)(F.ws + WS_R1);
    const int* tok_e = (const int*)(F.ws + WS_MISC + MI_TOKE); const float* tok_g = (const float*)(F.ws + WS_MISC + MI_TOKG); const int* tok_r = (const int*)(F.ws + WS_MISC + MI_TOKR);
    int* tok_s = (int*)(F.ws + WS_MISC + MI_TOKS); const int* cnt = (const int*)(F.ws + WS_MISC + MI_CNT); unsigned* hdr = (unsigned*)(F.ws + WS_MISC + MI_HDR);
    const float* tok_rs = (const float*)(F.ws + WS_MISC + MI_TOKRS); float* rsg = (float*)(F.ws + WS_MISC + MI_RSG); float* gtg = (float*)(F.ws + WS_MISC + MI_GTG);
    LAS int* part = (LAS int*)(F.lds);
    LAS int* fin = (LAS int*)(F.lds + 256);
    const int l = F.lane;
    for (int vb = opaque_s((int)blockIdx.x); vb < M / 64; vb += F.G) {
        const int pr_ = 16 * F.wave + (l & 15), tk_ = 64 * vb + (pr_ >> 1), kk_ = pr_ & 1; const int e_pre = tok_e[2 * tk_ + kk_], r_pre = tok_r[2 * tk_ + kk_]; const float rs_pre = tok_rs[tk_], g_pre = tok_g[2 * tk_ + kk_];
#if MOE_FP8
        v4u ra0[8], rb0[8];
#pragma unroll
        for (int j = 0; j < 8; ++j) { const int t = 64 * vb + ((16 * F.wave + j) >> 1); ra0[j] = *(const GAS v4u*)(xb + (size_t)t * 1024 + 16 * l); rb0[j] = *(const GAS v4u*)(xb + (size_t)t * 1024 + 16 * l + 8); }
#endif
        if (F.tid < 256) { int c[16];
            const v4u c0 = *(const GAS v4u*)(cnt + F.tid * NE), c1 = *(const GAS v4u*)(cnt + F.tid * NE + 4);
            c[0] = (int)c0.x; c[1] = (int)c0.y; c[2] = (int)c0.z; c[3] = (int)c0.w; c[4] = (int)c1.x; c[5] = (int)c1.y; c[6] = (int)c1.z; c[7] = (int)c1.w;
#pragma unroll
            for (int e = 0; e < NE; ++e) c[8 + e] = (F.tid < vb) ? c[e] : 0;
#pragma unroll
            for (int st = 0; st < 4; ++st) { const int off = 32 >> st, n = 16 >> st;
#pragma unroll
                for (int i = 0; i < 8; ++i) if (i < n / 2) { const bool hi = (l & off) != 0; const int keep = hi ? c[i + n / 2] : c[i], send = hi ? c[i] : c[i + n / 2]; c[i] = keep + __shfl_xor(send, off); } }
            int tot = c[0]; tot += __shfl_xor(tot, 2); tot += __shfl_xor(tot, 1);
            if ((l & 3) == 0) part[F.wave * 16 + (l >> 2)] = tot; }
        __syncthreads();
        if (F.tid == 0) { int off = 0;
            for (int e = 0; e < NE; ++e) { const int tot = part[e] + part[16 + e] + part[32 + e] + part[48 + e], bas = part[8 + e] + part[24 + e] + part[40 + e] + part[56 + e];
                const int pc = (tot + 255) & ~255; fin[e] = off + bas; fin[8 + e] = pc; off += pc; } }
        __syncthreads();
        if (vb == 0 && F.tid == 0) { unsigned p = 0; for (int e = 0; e < NE; ++e) { const int np_e = fin[8 + e] >> 8; for (int i = 0; i < np_e; ++i) hdr[1 + p++] = (unsigned)e; } hdr[0] = p; }
        int slot = 0;
        { slot = fin[e_pre] + r_pre;
          if (l < 16) { rsg[slot] = rs_pre; gtg[slot] = g_pre; tok_s[2 * tk_ + kk_] = slot; } }
#pragma unroll
        for (int bt = 0; bt < 2; ++bt) {
#if MOE_FP8
            v4u ra[8], rb[8];
#pragma unroll
            for (int j = 0; j < 8; ++j) { if (bt == 0) { ra[j] = ra0[j]; rb[j] = rb0[j]; } else { const int t = 64 * vb + ((16 * F.wave + 8 * bt + j) >> 1); ra[j] = *(const GAS v4u*)(xb + (size_t)t * 1024 + 16 * l); rb[j] = *(const GAS v4u*)(xb + (size_t)t * 1024 + 16 * l + 8); } }
#pragma unroll
            for (int j = 0; j < 8; ++j) { const int sl = __builtin_amdgcn_readlane(slot, 8 * bt + j); const v4u a = ra[j], b = rb[j];
                const pg8::u32x2 lo = pg8::pack8_fp8((f32x4){bf_lo(a.x), bf_hi(a.x), bf_lo(a.y), bf_hi(a.y)}, (f32x4){bf_lo(a.z), bf_hi(a.z), bf_lo(a.w), bf_hi(a.w)});
                const pg8::u32x2 hi = pg8::pack8_fp8((f32x4){bf_lo(b.x), bf_hi(b.x), bf_lo(b.y), bf_hi(b.y)}, (f32x4){bf_lo(b.z), bf_hi(b.z), bf_lo(b.w), bf_hi(b.w)});
                v4u o; o.x = lo.x; o.y = lo.y; o.z = hi.x; o.w = hi.y; *(GAS v4u*)((unsigned char*)xg + (size_t)sl * 1024 + 16 * l) = o; }
#else
            v4u ra[8], rb[8];
#pragma unroll
            for (int j = 0; j < 8; ++j) { const int t = 64 * vb + ((16 * F.wave + 8 * bt + j) >> 1); ra[j] = *(const GAS v4u*)(xb + (size_t)t * 1024 + 8 * l); rb[j] = *(const GAS v4u*)(xb + (size_t)t * 1024 + 512 + 8 * l); }
#pragma unroll
            for (int j = 0; j < 8; ++j) { const int sl = __builtin_amdgcn_readlane(slot, 8 * bt + j); *(GAS v4u*)(xg + (size_t)sl * 1024 + 8 * l) = ra[j]; *(GAS v4u*)(xg + (size_t)sl * 1024 + 512 + 8 * l) = rb[j]; }
#endif
        }
        __syncthreads();
    }
}
__device__ __forceinline__ void combine_phase(Frame& F, float* ssq_next, bool last) {
    float* const OUTP = (float*)F.in[24];
    bf16* xb = (bf16*)(F.ws + WS_XB); const bf16* og = (const bf16*)(F.ws + WS_R2); const int* tok_s = (const int*)(F.ws + WS_MISC + MI_TOKS);
    const int gw = F.vcu * NWAVES + F.wave, NGW = F.G * NWAVES, l = F.lane;
    for (int tb = 2 * gw; tb < M; tb += 2 * NGW) {
        const int sl = (l < 4) ? tok_s[2 * tb + l] : 0;
        int s[4];
#pragma unroll
        for (int i = 0; i < 4; ++i) s[i] = __builtin_amdgcn_readlane(sl, i);
#if MOE_OG8
        v4u xr[2][2]; v2u ar[2][2], br[2][2]; const unsigned char* og8 = (const unsigned char*)og;
#pragma unroll
        for (int q = 0; q < 2; ++q)
#pragma unroll
            for (int hh = 0; hh < 2; ++hh) { const int c0 = 512 * hh + 8 * l; xr[q][hh] = *(const GAS v4u*)(xb + (size_t)(tb + q) * 1024 + c0); ar[q][hh] = *(const GAS v2u*)(og8 + (size_t)s[2 * q] * 1024 + c0); br[q][hh] = *(const GAS v2u*)(og8 + (size_t)s[2 * q + 1] * 1024 + c0); }
#else
        v4u xr[2][2], ar[2][2], br[2][2];
#pragma unroll
        for (int q = 0; q < 2; ++q)
#pragma unroll
            for (int hh = 0; hh < 2; ++hh) { const int c0 = 512 * hh + 8 * l; xr[q][hh] = *(const GAS v4u*)(xb + (size_t)(tb + q) * 1024 + c0); ar[q][hh] = *(const GAS v4u*)(og + (size_t)s[2 * q] * 1024 + c0); br[q][hh] = *(const GAS v4u*)(og + (size_t)s[2 * q + 1] * 1024 + c0); }
#endif
#pragma unroll
        for (int q = 0; q < 2; ++q) { const int t = tb + q;
            float xn[16]; float ss = 0.f;
#pragma unroll
#if MOE_OG8
            for (int hh = 0; hh < 2; ++hh) { const v4u x = xr[q][hh]; const v2u a = ar[q][hh], b = br[q][hh];
#pragma unroll
                for (int d = 0; d < 2; ++d) {
                    const f32x2 a0 = __builtin_amdgcn_cvt_pk_f32_fp8((int)a[d], false), a1 = __builtin_amdgcn_cvt_pk_f32_fp8((int)a[d], true), b0 = __builtin_amdgcn_cvt_pk_f32_fp8((int)b[d], false), b1 = __builtin_amdgcn_cvt_pk_f32_fp8((int)b[d], true);
                    xn[8 * hh + 4 * d + 0] = bf_lo(x[2 * d]) + (a0.x + b0.x) * pg8::OG8_INV; xn[8 * hh + 4 * d + 1] = bf_hi(x[2 * d]) + (a0.y + b0.y) * pg8::OG8_INV;
                    xn[8 * hh + 4 * d + 2] = bf_lo(x[2 * d + 1]) + (a1.x + b1.x) * pg8::OG8_INV; xn[8 * hh + 4 * d + 3] = bf_hi(x[2 * d + 1]) + (a1.y + b1.y) * pg8::OG8_INV; } }
#else
            for (int hh = 0; hh < 2; ++hh) { const v4u x = xr[q][hh], a = ar[q][hh], b = br[q][hh];
#pragma unroll
                for (int k = 0; k < 4; ++k) { xn[8 * hh + 2 * k] = bf_lo(x[k]) + bf_lo(a[k]) + bf_lo(b[k]); xn[8 * hh + 2 * k + 1] = bf_hi(x[k]) + bf_hi(a[k]) + bf_hi(b[k]); } }
#endif
#pragma unroll
            for (int i = 0; i < 16; ++i) ss += xn[i] * xn[i];
            ss = wave_sum(ss);
            if (!last) {
#pragma unroll
                for (int hh = 0; hh < 2; ++hh) { v4u o;
#pragma unroll
                    for (int k = 0; k < 4; ++k) o[k] = cvt_pk_bf16(xn[8 * hh + 2 * k], xn[8 * hh + 2 * k + 1]);
                    *(GAS v4u*)(xb + (size_t)t * 1024 + 512 * hh + 8 * l) = o;
                    if (MIX8IN_L2 != 0) { int lo = 0, hi = 0; lo = __builtin_amdgcn_cvt_pk_fp8_f32(xn[8 * hh], xn[8 * hh + 1], lo, false); lo = __builtin_amdgcn_cvt_pk_fp8_f32(xn[8 * hh + 2], xn[8 * hh + 3], lo, true);
                        hi = __builtin_amdgcn_cvt_pk_fp8_f32(xn[8 * hh + 4], xn[8 * hh + 5], hi, false); hi = __builtin_amdgcn_cvt_pk_fp8_f32(xn[8 * hh + 6], xn[8 * hh + 7], hi, true);
                        v2u o8; o8.x = (unsigned)lo; o8.y = (unsigned)hi; *(GAS v2u*)(F.ws + WS_R3 + (size_t)t * 1024 + 512 * hh + 8 * l) = o8; } }
                ssq_store_row(ssq_next, t, l, ss);
            } else { const float r = __builtin_amdgcn_rsqf(ss * (1.0f / 1024.0f) + RMS_EPS);
#pragma unroll
                for (int hh = 0; hh < 2; ++hh) { const int c0 = 512 * hh + 8 * l; const f32x4 g0 = *(const GAS f32x4*)(F.in[23] + c0), g1 = *(const GAS f32x4*)(F.in[23] + c0 + 4);
                    f32x4 o0, o1;
#pragma unroll
                    for (int k = 0; k < 4; ++k) { o0[k] = xn[8 * hh + k] * r * g0[k]; o1[k] = xn[8 * hh + 4 + k] * r * g1[k]; }
                    *(GAS f32x4*)(OUTP + (size_t)t * 1024 + c0) = o0; *(GAS f32x4*)(OUTP + (size_t)t * 1024 + c0 + 4) = o1; }
            }
        }
    }
}
__device__ __forceinline__ void finalize_phase(Frame& F) {
    float* const OUTP = (float*)F.in[24];
    const bf16* xb = (const bf16*)(F.ws + WS_XB);
    const int gw = F.vcu * NWAVES + F.wave, NGW = F.G * NWAVES, l = F.lane;
    for (int t = gw; t < M; t += NGW) {
        float xn[16]; float ss = 0.f;
#pragma unroll
        for (int hh = 0; hh < 2; ++hh) { const v4u x = *(const GAS v4u*)(xb + (size_t)t * 1024 + 512 * hh + 8 * l);
#pragma unroll
            for (int k = 0; k < 4; ++k) { xn[8 * hh + 2 * k] = bf_lo(x[k]); xn[8 * hh + 2 * k + 1] = bf_hi(x[k]); } }
#pragma unroll
        for (int i = 0; i < 16; ++i) ss += xn[i] * xn[i];
        ss = wave_sum(ss); const float r = __builtin_amdgcn_rsqf(ss * (1.0f / 1024.0f) + RMS_EPS);
#pragma unroll
        for (int hh = 0; hh < 2; ++hh) { const int c0 = 512 * hh + 8 * l; const f32x4 g0 = *(const GAS f32x4*)(F.in[23] + c0), g1 = *(const GAS f32x4*)(F.in[23] + c0 + 4);
            f32x4 o0, o1;
#pragma unroll
            for (int k = 0; k < 4; ++k) { o0[k] = xn[8 * hh + k] * r * g0[k]; o1[k] = xn[8 * hh + 4 + k] * r * g1[k]; }
            *(GAS f32x4*)(OUTP + (size_t)t * 1024 + c0) = o0; *(GAS f32x4*)(OUTP + (size_t)t * 1024 + c0 + 4) = o1; }
    }
}

#if MK_PER_PHASE
struct BarT { int unused; };
#define GRID_BAR() do { } while (0)
#else
typedef XcdBarrier BarT;
#define GRID_BAR() xcd_barrier(bar_)
#endif
#ifndef PH_ENABLE
#define PH_ENABLE 0x3fff
#endif
#define PH_ON(j) (((PH_ENABLE) >> (j)) & 1)
#ifndef DUP_MASK
#define DUP_MASK 0
#endif
#define NREP(j) ((((DUP_MASK) >> (j)) & 1) ? 2 : 1)
#define IN(k) (lo <= (k) && (k) < hi && (k) <= MK_LAST_PHASE)
#ifdef BAR_TWICE
#define SEAM(k) do { if (IN(k) && (k) + 1 < hi) { GRID_BAR(); GRID_BAR(); } } while (0)
#else
#if BAR_FILL && FILL_TAILS && !MK_PER_PHASE
#define SEAM(k) do { if (IN(k) && (k) + 1 < hi) { if ((k) < BF_SLOTS) xcd_barrier_fill(bar_, F, (k)); else GRID_BAR(); } } while (0)
#else
#if !MK_PER_PHASE
#define SEAM_LOCAL(k) ((k) >= 1 && ((((k) - 1) % 13) == 1 || (((k) - 1) % 13) == 2 || (((k) - 1) % 13) == 3 || (((k) - 1) % 13) == 6 || (((k) - 1) % 13) == 7))
#define SEAM(k) do { if (IN(k) && (k) + 1 < hi) { if (LOCAL_BAR != 0 && SEAM_LOCAL(k) && bar_.st[2] != 0u) xcd_local_barrier(bar_); else GRID_BAR(); } } while (0)
#else
#define SEAM(k) do { if (IN(k) && (k) + 1 < hi) GRID_BAR(); } while (0)
#endif
#endif
#endif
#define xb ((bf16*)(wsl + WS_XB))
#define r1 ((bf16*)(wsl + WS_R1))
#define r1b ((bf16*)(wsl + WS_R1 + 32 * MiB))
#define r2 ((bf16*)(wsl + WS_R2))
#define r3 ((bf16*)(wsl + WS_R3))
#define x8a ((bf16*)(wsl + WS_R3 + 128 * MiB))
#define x8b ((bf16*)(wsl + WS_R3 + 144 * MiB))
#define SQ(s) ((float*)(wsl + WS_SSQ) + (size_t)(s) * 4 * M)
#define LOCALF() Frame Fl = F; Fl.tid = opaque_v(F.tid); Fl.lane = Fl.tid & 63; Fl.wave = opaque_s(F.wave); Fl.vcu = opaque_s(F.vcu); Fl.in = opaque_tab(F.in); Fl.ws = wsl; const int bx = opaque_s(bx0); (void)bx
#define PH_BEGIN(j, id) if (PH_ON(j) && IN(id)) { _Pragma("unroll 1") for (int rep_ = 0; rep_ < NREP(j); ++rep_) { if (rep_) GRID_BAR(); GAS unsigned char* wsl = F.ws; asm volatile("" : "+s"(wsl));
#define PH_END(id) } } SEAM(id);
template <int lp> __device__ __forceinline__ void pair_body(Frame& F, const BarT& bar_, const int lo, const int hi, const int bx0) {
        const int pb = 1 + 13 * lp;
        PH_BEGIN(0, pb + 0) const int bx = opaque_s(bx0); constexpr bool I8 = (MIX8IN_L2 != 0 && lp == 1); pg8::Gemm g{I8 ? r3 : xb, ev_wl(wsl, lp, EVO_WIN), M, EV_IN, D}; pg8::StaticOrder S; S.init(M, EV_IN, F.G, bx, WGM_E1);
            pg8::EpiEvenInT<I8> E{r1, r1b, SQ(4 * lp), (pg8::f32x2*)(wsl + WS_MISC + MI_LNA)}; pg8::gemm_phase<pg8::EpiEvenInT<I8>, pg8::StaticOrder, EPI_ALIGN_HEAVY, true, I8>(F.lds, g, S, E); PH_END(pb + 0)
        PH_BEGIN(1, pb + 1) LOCALF(); for (int u = Fl.vcu; u < 256; u += F.G) {     MixBTile BT; int tid_; _Pragma("unroll 1") for (int ra = 0; ra < NREP(14); ++ra) mix_unit_a(Fl, lp, u >> 1, u & 1, u, BT, tid_); _Pragma("unroll 1") for (int rb = 0; rb < NREP(15); ++rb) mix_unit_b(Fl, lp, u, tid_, BT); } PH_END(pb + 1)
        PH_BEGIN(2, pb + 2) const int bx = opaque_s(bx0); pg8::Gemm g{r2, ev_wl(wsl, lp, EVO_WOUT), M, D, D}; pg8::StaticOrder S; S.init(M, D, F.G, bx, WGM_N4);
            constexpr bool X8 = (FFN2_FP8 && lp == 1), O8 = (MIX8OUT_L2 != 0 && lp == 1); pg8::EpiRes<X8, O8> E{xb, SQ(4 * lp + 1), (unsigned char*)x8a, (LAS float*)(F.lds + RED_OFF)}; pg8::gemm_phase<pg8::EpiRes<X8, O8>, pg8::StaticOrder, true, true, O8>(F.lds, g, S, E); PH_END(pb + 2)
        PH_BEGIN(3, pb + 3) const int bx = opaque_s(bx0); constexpr bool F8 = (FFN2_FP8 && lp == 1); pg8::Gemm g{F8 ? x8a : xb, ev_wl(wsl, lp, EVO_W13), M, NFF2, D}; pg8::StaticOrder S; S.init(M, NFF2, F.G, bx, WGM_E4);
            constexpr bool O8 = F8 || (DOWN8_L0 != 0 && lp == 0); typedef pg8::EpiGlu<false, O8, F8 && (GLU_WT != 0)> EpiE4; EpiE4 E{r3, DFF, SQ(4 * lp + 1), F8 ? pg8::W8_INV : 1.0f, F.lds + STG_OFF}; if (fill_idle(S.nwg, F.G, bx)) stagger_wait(bx, F8 ? 1600 : 2800); pg8::gemm_phase<EpiE4, pg8::StaticOrder, EPI_ALIGN_HEAVY, true, F8>(F.lds, g, S, E);
            if constexpr (lp == 0) { if (fill_idle(S.nwg, F.G, bx)) { LOCALF(); fill_convert(Fl, FILL_N_E4); } } PH_END(pb + 3)
        PH_BEGIN(4, pb + 4) const int bx = opaque_s(bx0); pg8::Gemm g{r3, ev_wl(wsl, lp, EVO_W2), M, D, DFF}; pg8::StaticOrder S; S.init(M, D, F.G, bx, WGM_N4);
            constexpr bool F8 = (FFN2_FP8 && lp == 1) || (DOWN8_L0 != 0 && lp == 0); constexpr bool XO = (MIX8_L3 != 0 && lp == 1); pg8::EpiRes<XO, F8> E{xb, SQ(4 * lp + 2), (unsigned char*)x8b, (LAS float*)(F.lds + RED_OFF)}; pg8::gemm_phase<pg8::EpiRes<XO, F8>, pg8::StaticOrder, true, true, F8>(F.lds, g, S, E); PH_END(pb + 4)
        PH_BEGIN(5, pb + 5) const int bx = opaque_s(bx0); constexpr bool M8 = (MIX8_L3 != 0 && lp == 1); pg8::Gemm g{M8 ? x8b : xb, od_wl(wsl, lp, ODO_WIN), M, OD_IN, D}; pg8::StaticOrder S; S.init(M, OD_IN, F.G, bx, WGM_O1);
            pg8::EpiOddInT<M8> E{r1, r1b, SQ(4 * lp + 2)}; pg8::gemm_phase<pg8::EpiOddInT<M8>, pg8::StaticOrder, EPI_ALIGN_HEAVY, true, M8>(F.lds, g, S, E); PH_END(pb + 5)
        PH_BEGIN(6, pb + 6) LOCALF(); conv3_phase(Fl, lp); PH_END(pb + 6)
        PH_BEGIN(7, pb + 7) const int bx = opaque_s(bx0); pg8::Gemm g{r2, od_wl(wsl, lp, ODO_WOUT), M, D, D}; pg8::StaticOrder S; S.init(M, D, F.G, bx, WGM_N4);
            constexpr bool M8 = (MIX8_L3 != 0 && lp == 1); pg8::EpiRes<false, M8> E{xb, SQ(4 * lp + 3), nullptr, (LAS float*)(F.lds + RED_OFF)}; pg8::gemm_phase<pg8::EpiRes<false, M8>, pg8::StaticOrder, true, true, M8>(F.lds, g, S, E); PH_END(pb + 7)
        PH_BEGIN(8, pb + 8) LOCALF(); router_phase(Fl, lp, SQ(4 * lp + 3)); PH_END(pb + 8)
        PH_BEGIN(9, pb + 9) LOCALF(); gather_phase(Fl); PH_END(pb + 9)
        PH_BEGIN(10, pb + 10) const int bx = opaque_s(bx0); const unsigned* hdr = (const unsigned*)(wsl + WS_MISC + MI_HDR);
            int np = __builtin_amdgcn_readfirstlane((int)__hip_atomic_load(hdr, RLX_AGENT)); np = np > MAXP ? MAXP : np;
            { LAS unsigned* ptab = (LAS unsigned*)(F.lds + PTAB_OFF); const int tid_ = opaque_v(F.tid); if (tid_ < MAXP) ptab[tid_] = (tid_ < np) ? __hip_atomic_load(hdr + 1 + tid_, RLX_AGENT) : 0u; __syncthreads(); }
            constexpr bool CH = MOE_CHAIN != 0; typedef pg8::MoeOrderT<CH, false> OrdT; typedef pg8::EpiGlu<true, MOE_FP8 != 0, CH || (GLU_WT != 0 && MOE_FP8 != 0)> EpiT;
            pg8::Gemm g{r1, od_wl(wsl, lp, ODO_W13), np * 256, NFF2, D};
            OrdT S; S.init(np * 256, NFF2, F.G, bx, WGM_O6); S.tab = (const LAS unsigned*)(F.lds + PTAB_OFF); S.estride = (size_t)NFF2 * D * (MOE_FP8 ? 1 : 2);
            S.cnt = (unsigned*)((gu32*)(wsl + WS_CTL) + CW_PCNT + lp * PCNT_WORDS); S.need = 0u; S.tmo = (unsigned*)((gu32*)(wsl + WS_CTL) + CW_TMO);
            EpiT E{r3, DFF, (const float*)(wsl + WS_MISC + MI_RSG), MOE_FP8 ? pg8::W8_INV : 1.0f, F.lds + STG_OFF}; if (fill_idle(S.nwg, F.G, bx)) stagger_wait(bx, MOE_FP8 ? 1700 : 3000);
#if XCD_STAGGER
            if (bx & 1) half_unit_wait(XCD_STAGGER);
#endif
#ifdef PROBE_FAKE
            if (NREP(10) == 2 && rep_ == 0) pg8::gemm_phase<EpiT, OrdT, EPI_ALIGN_HEAVY, F8_SP2, MOE_FP8 != 0, true>(F.lds, g, S, E); else
#endif
            pg8::gemm_phase<EpiT, OrdT, EPI_ALIGN_HEAVY, F8_SP2, MOE_FP8 != 0>(F.lds, g, S, E);
            if constexpr (lp == 0 && !CH) { if (fill_idle(S.nwg, F.G, bx)) { LOCALF(); fill_convert(Fl, 3); } }
#if MOE_CHAIN
        } }
#else
        PH_END(pb + 10)
#endif
        PH_BEGIN(11, pb + 11) const int bx = opaque_s(bx0); const unsigned* hdr = (const unsigned*)(wsl + WS_MISC + MI_HDR);
            int np = __builtin_amdgcn_readfirstlane((int)__hip_atomic_load(hdr, RLX_AGENT)); np = np > MAXP ? MAXP : np;
            { LAS unsigned* ptab = (LAS unsigned*)(F.lds + PTAB_OFF); const int tid_ = opaque_v(F.tid); if (tid_ < MAXP) ptab[tid_] = (tid_ < np) ? __hip_atomic_load(hdr + 1 + tid_, RLX_AGENT) : 0u; __syncthreads(); }
            constexpr bool CH = MOE_CHAIN != 0; typedef pg8::MoeOrderT<false, CH> OrdT;
            const int cdeal = CH ? (bx - (np * (NFF2 / 256)) % F.G + F.G) % F.G : bx;
            pg8::Gemm g{r3, od_wl(wsl, lp, ODO_W2), np * 256, D, DFF}; OrdT S; S.init(np * 256, D, F.G, cdeal, WGM_O7); S.tab = (const LAS unsigned*)(F.lds + PTAB_OFF); S.estride = (size_t)D * DFF * (MOE_FP8 ? 1 : 2);
            S.cnt = (unsigned*)((gu32*)(wsl + WS_CTL) + CW_PCNT + lp * PCNT_WORDS); S.need = (unsigned)((NFF2 / 256) * NWAVES); S.tmo = (unsigned*)((gu32*)(wsl + WS_CTL) + CW_TMO);
            pg8::EpiMoeDown<MOE_OG8 != 0> E{r2, (const float*)(wsl + WS_MISC + MI_GTG), MOE_FP8 ? pg8::W8_INV : 1.0f}; if (fill_idle(S.nwg, F.G, cdeal)) stagger_wait(cdeal, MOE_FP8 ? 3500 : 7000); pg8::gemm_phase<pg8::EpiMoeDown<MOE_OG8 != 0>, OrdT, true, F8_SP2, MOE_FP8 != 0>(F.lds, g, S, E);
            if constexpr (lp == 0) { if (fill_idle(S.nwg, F.G, cdeal)) { LOCALF(); fill_convert(Fl, FILL_N_O7); } } PH_END(pb + 11)
        PH_BEGIN(12, pb + 12) LOCALF(); combine_phase(Fl, SQ((4 * lp + 4) & 7), lp == 1); if constexpr (lp == 0) fill_convert(Fl, 1 << 30); PH_END(pb + 12)
    }


struct Args { const float* in[24]; float* out; unsigned char* ws; int ph_lo, ph_hi; };
__global__ void __launch_bounds__(NWAVES * 64, 2) enc_fwd(Args args) {
    extern __shared__ __attribute__((aligned(16))) unsigned char lds[];
    Frame F;
    F.lds = (LAS unsigned char*)lds;
    F.MISC = (volatile LAS unsigned*)(F.lds + MISC_OFF);
    F.tid = threadIdx.x; F.lane = F.tid & 63; F.wave = __builtin_amdgcn_readfirstlane(F.tid >> 6);
    F.G = gridDim.x; { const int bx = blockIdx.x; F.vcu = (F.G % 8 == 0) ? (bx % 8) * (F.G / 8) + bx / 8 : bx; }
    F.ws = (GAS unsigned char*)args.ws;
    F.in = (intab_t)__builtin_amdgcn_kernarg_segment_ptr();
    for (int u = F.tid; u < 128; u += NWAVES * 64) ((LAS unsigned*)(F.lds + MISC_OFF))[u] = 0u;
    __syncthreads();
#if MK_PER_PHASE
    const BarT bar_{0};
#else
    const BarT bar_ = xcd_barrier_post((unsigned*)((gu32*)(F.ws + WS_CTL) + CW_BAR), F.MISC + 8);
#endif
    const int lo = args.ph_lo, hi = args.ph_hi;
    const int bx0 = (int)blockIdx.x;
    PH_BEGIN(13, 0) LOCALF(); p0_prologue(Fl); PH_END(0)

    pair_body<0>(F, bar_, lo, hi, bx0);
    pair_body<1>(F, bar_, lo, hi, bx0);
#if MK_LAST_PHASE < 26
    if (hi == NPHASE + 1) { if (lo < NPHASE) GRID_BAR(); LOCALF(); finalize_phase(Fl); }
#endif
#undef IN
#undef xb
#undef r1
#undef r1b
#undef r2
#undef r3
#undef x8a
#undef x8b
#undef SQ
#undef SEAM
}

extern "C" void kernel_launch(void* const* d_in, const int* in_sizes, int n_in, void* d_out, int out_size, void* d_ws, size_t ws_size, hipStream_t stream) {
    static int grid = 0;
    if (grid == 0) {
        if (n_in != 24 || in_sizes[0] != M * D || out_size != M * D || ws_size < WS_END) { fprintf(stderr, "kernel_launch: unexpected shapes (n_in %d, in0 %d, out %d, ws %zu < %zu); nothing launched\n", n_in, n_in > 0 ? in_sizes[0] : -1, out_size, ws_size, (size_t)WS_END); grid = -1; return; }
        int dev = 0, cus = 0, per_cu = 0;
        if (hipGetDevice(&dev) != hipSuccess || hipDeviceGetAttribute(&cus, hipDeviceAttributeMultiprocessorCount, dev) != hipSuccess) { grid = -1; return; }
        if (hipFuncSetAttribute((const void*)enc_fwd, hipFuncAttributeMaxDynamicSharedMemorySize, LDS_BYTES) != hipSuccess) { fprintf(stderr, "kernel_launch: hipFuncSetAttribute failed\n"); grid = -1; return; }
        if (hipOccupancyMaxActiveBlocksPerMultiprocessor(&per_cu, (const void*)enc_fwd, NWAVES * 64, LDS_BYTES) != hipSuccess || per_cu < 1) fprintf(stderr, "kernel_launch: note: occupancy query reports %d workgroups per CU\n", per_cu);
        (void)hipGetLastError();
        grid = cus;
    }
    if (grid < 0) return;
    if (hipMemsetAsync((char*)d_ws + WS_CTL, 0, CTL_ZERO_BYTES, stream) != hipSuccess) { fprintf(stderr, "kernel_launch: hipMemsetAsync failed\n"); return; }
    Args a{};
    for (int i = 0; i < 24; ++i) a.in[i] = (const float*)d_in[i];
    a.out = (float*)d_out; a.ws = (unsigned char*)d_ws;
    constexpr int NPH_RUN = (MK_LAST_PHASE < 26) ? NPHASE + 1 : NPHASE;
#if MK_PER_PHASE
    for (int p = 0; p < NPH_RUN; ++p) { if (p < NPHASE && p > MK_LAST_PHASE) continue; a.ph_lo = p; a.ph_hi = p + 1;
        hipLaunchKernelGGL(enc_fwd, dim3(grid), dim3(NWAVES * 64), LDS_BYTES, stream, a); }
#else
    a.ph_lo = 0; a.ph_hi = NPH_RUN;
    hipLaunchKernelGGL(enc_fwd, dim3(grid), dim3(NWAVES * 64), LDS_BYTES, stream, a);
#endif
    const hipError_t le = hipPeekAtLastError();
    if (le != hipSuccess) fprintf(stderr, "kernel_launch: launch failed: %s\n", hipGetErrorName(le));
}
```

```cpp
#include <hip/hip_runtime.h>
#include <cstdio>

namespace pg8 {
#define PG8_LAS __attribute__((address_space(3)))
typedef unsigned short bf16_t;
typedef short bf16x8 __attribute__((ext_vector_type(8)));
typedef float f32x4 __attribute__((ext_vector_type(4)));
typedef float f32x2 __attribute__((ext_vector_type(2)));
typedef unsigned u32x4 __attribute__((ext_vector_type(4)));
typedef unsigned u32x2 __attribute__((ext_vector_type(2)));
typedef int v4i32 __attribute__((ext_vector_type(4)));
typedef int v8i32 __attribute__((ext_vector_type(8)));
constexpr int BM = 256, BK = 64, HALF = 128, HTB = HALF * BK * 2  , STAGE_BYTES = 8 * HTB, NXCD = 8;

__host__ __device__ __forceinline__ int lds_byte(int r, int c) { const int st = (r >> 4) * 2 + (c >> 5), rr = r & 15, cc = c & 31, ob = rr * 64 + cc * 2; return st * 1024 + (ob ^ (((ob >> 9) & 1) << 5)); }
__host__ __device__ __forceinline__ void stage_rc(int b, int& R, int& C) { const int st = b / 1024, sb = b % 1024, swz = sb ^ (((sb >> 9) & 1) << 5); R = (st >> 1) * 16 + swz / 64; C = (st & 1) * 32 + (swz % 64) / 2; }
__host__ __device__ __forceinline__ int perm32(int rho) { const int n = rho >> 4, i = rho & 15; return 8 * (i >> 2) + 4 * n + (i & 3); }

struct Unit { int pm, pn; };
struct Gemm { const bf16_t* A; const bf16_t* Bt; int M, N, K; };

struct StaticOrder {
    int nM, nN, nwg, G, c, wgm;
    __host__ __device__ void init(int M, int N, int G_, int c_, int wgm_ = 2) { nM = M / BM; nN = N / BM; nwg = nM * nN; G = G_; c = c_; wgm = wgm_; }
    __host__ __device__ bool next(int i, Unit& u) const {
        const long L = (long)i * G + c; if (L >= nwg) return false;
        int wgid = (int)L; { const int q = nwg / NXCD, r = nwg % NXCD, xcd = wgid % NXCD, off = wgid / NXCD; wgid = (xcd < r ? xcd * (q + 1) : r * (q + 1) + (xcd - r) * q) + off; }
        const int nig = wgm * nN, gid = wgid / nig, fm = gid * wgm, gsz = (nM - fm) < wgm ? (nM - fm) : wgm;
        const int w = wgid % nig;
        if (gsz == wgm && (wgm & (wgm - 1)) == 0) { u.pm = fm + (w & (wgm - 1)); u.pn = w >> __builtin_ctz(wgm); }
        else { u.pm = fm + (w % gsz); u.pn = w / gsz; }
        return true;
    }
    static constexpr bool PUBD = false;
    __device__ __forceinline__ size_t b_off(const Unit&) const { return 0; }
    __device__ __forceinline__ void a_ready(const Unit&) const {}
    __device__ __forceinline__ void done(const Unit&) const {}
    __device__ __forceinline__ void publish(int) const {}
};
template <bool PUB, bool GATE> struct MoeOrderT : StaticOrder {
    const PG8_LAS unsigned* tab; size_t estride; unsigned* cnt; unsigned need; unsigned* tmo;
    __device__ __forceinline__ size_t b_off(const Unit& u) const {
        const unsigned e = (unsigned)__builtin_amdgcn_readfirstlane((int)tab[u.pm]);
        return (size_t)e * estride;
    }
    __device__ __forceinline__ void a_ready(const Unit& u) const {
        if constexpr (GATE) {
            if (threadIdx.x < 64) {
                const unsigned long long t0 = __builtin_amdgcn_s_memrealtime(); unsigned polls = 0;
                while ((unsigned)__builtin_amdgcn_readfirstlane((int)__hip_atomic_load(cnt + 64 * u.pm, __ATOMIC_RELAXED, __HIP_MEMORY_SCOPE_AGENT)) < need) {
                    if ((++polls & 255u) == 0u && __builtin_amdgcn_readfirstlane((int)__hip_atomic_load(tmo, __ATOMIC_RELAXED, __HIP_MEMORY_SCOPE_AGENT)) != 0) break;
                    if (__builtin_amdgcn_s_memrealtime() - t0 > 2000000ull) { if (threadIdx.x == 0) __hip_atomic_store(tmo, 1u, __ATOMIC_RELAXED, __HIP_MEMORY_SCOPE_AGENT); break; }
                    __builtin_amdgcn_s_sleep(2); }
                __builtin_amdgcn_fence(__ATOMIC_ACQUIRE, "agent");
                asm volatile("s_waitcnt vmcnt(0)" ::: "memory");
            }
            asm volatile("" ::: "memory"); __builtin_amdgcn_s_barrier(); asm volatile("" ::: "memory");
        }
    }
    static constexpr bool PUBD = PUB;
    __device__ __forceinline__ void done(const Unit&) const {}
    __device__ __forceinline__ void publish(int pm) const { if constexpr (PUB) { if ((threadIdx.x & 63) == 0) __hip_atomic_fetch_add(cnt + 64 * pm, 1u, __ATOMIC_RELAXED, __HIP_MEMORY_SCOPE_AGENT); } }
};
typedef MoeOrderT<false, false> MoeOrder;

__device__ __forceinline__ unsigned cvt_pk_bf16(float lo, float hi) { unsigned r; asm volatile("v_cvt_pk_bf16_f32 %0, %1, %2" : "=v"(r) : "v"(lo), "v"(hi)); return r; }
__device__ __forceinline__ float bf_lo(unsigned w) { return __uint_as_float(w << 16); }
__device__ __forceinline__ float bf_hi(unsigned w) { return __uint_as_float(w & 0xffff0000u); }
__device__ __forceinline__ float sigmoidf_fast(float x) { return __builtin_amdgcn_rcpf(1.0f + __builtin_amdgcn_exp2f(x * -1.4426950408889634f)); }
__device__ __forceinline__ float siluf_fast(float x) { return x * sigmoidf_fast(x); }
__device__ __forceinline__ float gelu_tanh_fast(float x) { return x * sigmoidf_fast(1.5957691216057308f * (x + 0.044715f * x * x * x)); }
__device__ __forceinline__ f32x4 exp2_4(f32x4 x) { return (f32x4){__builtin_amdgcn_exp2f(x[0]), __builtin_amdgcn_exp2f(x[1]), __builtin_amdgcn_exp2f(x[2]), __builtin_amdgcn_exp2f(x[3])}; }
__device__ __forceinline__ f32x4 rcp_4(f32x4 x) { return (f32x4){__builtin_amdgcn_rcpf(x[0]), __builtin_amdgcn_rcpf(x[1]), __builtin_amdgcn_rcpf(x[2]), __builtin_amdgcn_rcpf(x[3])}; }
__device__ __forceinline__ f32x4 sigmoid_4(f32x4 x) { return rcp_4(exp2_4(x * -1.4426950408889634f) + 1.0f); }
__device__ __forceinline__ f32x4 gelu_tanh_4(f32x4 x) { return x * sigmoid_4((x * x * 0.044715f + 1.0f) * x * 1.5957691216057308f); }
#ifndef GEMM_BF16_ASM
#define GEMM_BF16_ASM 0
#endif
#ifndef GEMM_ZERO_C
#define GEMM_ZERO_C 1
#endif
#ifndef GLU_DEFER_STORES
#define GLU_DEFER_STORES 0
#endif
#ifndef GEMM_PRIO
#define GEMM_PRIO 1
#endif
#ifndef EPI_NT
#define EPI_NT 0
#endif
#ifndef GLU_T21
#define GLU_T21 0
#endif
#ifndef GLU_STAGE_STORES
#define GLU_STAGE_STORES 0
#endif
constexpr float RMS_EPS = 1e-6f;
constexpr int SSQ_M = 16384;
__device__ __forceinline__ float xor16_add(float v) { float a = v, b = v; asm volatile("s_nop 1\n\tv_permlane16_swap_b32 %0, %1" : "+v"(a), "+v"(b)); return a + b; }
__device__ __forceinline__ float xor32_add(float v) { float a = v, b = v; asm volatile("s_nop 1\n\tv_permlane32_swap_b32 %0, %1" : "+v"(a), "+v"(b)); return a + b; }
template <int CTRL> __device__ __forceinline__ float dpp_f(float v) { return __uint_as_float((unsigned)__builtin_amdgcn_update_dpp(0, (int)__float_as_uint(v), CTRL, 0xF, 0xF, true)); }
__device__ __forceinline__ float wave_sum_valu(float v) {
    v += dpp_f<0xB1>(v); v += dpp_f<0x4E>(v); v += dpp_f<0x141>(v); v += dpp_f<0x140>(v); v = xor16_add(v); return xor32_add(v); }
template <int OFF> __device__ __forceinline__ float xor_get(float x, int lane) {
    if constexpr (OFF == 32) { const auto r = __builtin_amdgcn_permlane32_swap(__float_as_uint(x), __float_as_uint(x), false, false); return __uint_as_float((lane & 32) ? r[0] : r[1]); }
    else if constexpr (OFF == 16) { const auto r = __builtin_amdgcn_permlane16_swap(__float_as_uint(x), __float_as_uint(x), false, false); return __uint_as_float((lane & 16) ? r[0] : r[1]); }
    else if constexpr (OFF == 8) return dpp_f<0x128>(x);
    else if constexpr (OFF == 4) { const float up = dpp_f<0x104>(x), dn = dpp_f<0x114>(x); return (lane & 4) ? dn : up; }
    else if constexpr (OFF == 2) return dpp_f<0x4E>(x);
    else return dpp_f<0xB1>(x);
}
template <class T> __device__ __forceinline__ void st_out(T* p, const T v) { if constexpr (EPI_NT != 0) __builtin_nontemporal_store(v, p); else *p = v; }
__device__ __forceinline__ float rstd_pf(float pf) { const float s = xor32_add(xor16_add(pf)); return __builtin_amdgcn_rsqf(s * (1.0f / 1024.0f) + RMS_EPS); }
struct NoState {};
#define PG8_NO_STATE typedef NoState State; __device__ __forceinline__ void init(State&) const {} __device__ __forceinline__ void flush(State&, int, int, int, int) const {}
template <int IMM> __device__ __forceinline__ float ld_pf(const float* base, unsigned voff) { float v; asm volatile("global_load_dword %0, %1, %2 offset:%3" : "=v"(v) : "v"(voff), "s"(base), "n"(IMM) : "memory"); return v; }
#define PG8_PF_ROWS(base, idx0) do { const unsigned voff_ = (unsigned)(idx0) * 4u; \
    pf[0] = ld_pf<0>(base, voff_); pf[1] = ld_pf<64>(base, voff_); pf[2] = ld_pf<128>(base, voff_); pf[3] = ld_pf<192>(base, voff_); \
    pf[4] = ld_pf<HALF * 4>(base, voff_); pf[5] = ld_pf<HALF * 4 + 64>(base, voff_); pf[6] = ld_pf<HALF * 4 + 128>(base, voff_); pf[7] = ld_pf<HALF * 4 + 192>(base, voff_); } while (0)
__device__ __forceinline__ u32x2 pack8_fp8(const f32x4 a, const f32x4 b) {
    int lo = 0, hi = 0; lo = __builtin_amdgcn_cvt_pk_fp8_f32(a[0], a[1], lo, false); lo = __builtin_amdgcn_cvt_pk_fp8_f32(a[2], a[3], lo, true);
    hi = __builtin_amdgcn_cvt_pk_fp8_f32(b[0], b[1], hi, false); hi = __builtin_amdgcn_cvt_pk_fp8_f32(b[2], b[3], hi, true); u32x2 w; w.x = (unsigned)lo; w.y = (unsigned)hi; return w; }
constexpr float W8_SCALE = 64.0f, W8_INV = 1.0f / 64.0f;
__device__ __forceinline__ u32x4 pack8(const f32x4 a, const f32x4 b) { u32x4 w; w.x = cvt_pk_bf16(a[0], a[1]); w.y = cvt_pk_bf16(a[2], a[3]); w.z = cvt_pk_bf16(b[0], b[1]); w.w = cvt_pk_bf16(b[2], b[3]); return w; }

template <bool SC8 = false> struct EpiEvenInT {
    static constexpr bool PERM = true, AFTER_DRAIN = false, IDEM = true;
    PG8_NO_STATE
    bf16_t* za; bf16_t* glu; const float* ssq; f32x2* lna;
    __device__ __forceinline__ void prefetch(const Unit& u, int wr, int wc, int fr, int fq, float (&pf)[8]) const { PG8_PF_ROWS(ssq, fq * SSQ_M + u.pm * BM + wr * 64 + fr); }
    __device__ __forceinline__ void operator()(const f32x4 (&acc)[2][2][4][2], const Unit& u, int wr, int wc, int fr, int fq, const float (&pf)[8], State& est) const {
        const int row0 = u.pm * BM + wr * 64 + fr;
        if (u.pn < 4) {
#pragma unroll
            for (int ai = 0; ai < 2; ++ai)
#pragma unroll
                for (int m = 0; m < 4; ++m) { const int row = row0 + ai * HALF + m * 16; const float r = rstd_pf(pf[ai * 4 + m]) * (SC8 ? W8_INV : 1.0f); bf16_t* rowp = za + (size_t)row * 1024 + u.pn * 256 + wc * 32 + 8 * fq; float s = 0.f, q = 0.f;
#pragma unroll
                    for (int bj = 0; bj < 2; ++bj) { f32x4 v0 = acc[ai][bj][m][0] * r, v1 = acc[ai][bj][m][1] * r;
#pragma unroll
                        for (int j = 0; j < 1; ++j) { v0 = gelu_tanh_4(v0); v1 = gelu_tanh_4(v1); const f32x4 sv = v0 + v1, qv = v0 * v0 + v1 * v1; s += (sv[0] + sv[1]) + (sv[2] + sv[3]); q += (qv[0] + qv[1]) + (qv[2] + qv[3]); }
                        *(u32x4*)(rowp + bj * HALF) = pack8(v0, v1); }
                    if (u.pn >= 2) { s = xor32_add(xor16_add(s)); q = xor32_add(xor16_add(q));
                        if (fq == 0) lna[(size_t)((u.pn - 2) * 4 + wc) * SSQ_M + row] = (f32x2){s, q}; } }
        } else {
            const int q = u.pn - 4;
#pragma unroll
            for (int ai = 0; ai < 2; ++ai)
#pragma unroll
                for (int m = 0; m < 4; ++m) { const int row = row0 + ai * HALF + m * 16; const float r = rstd_pf(pf[ai * 4 + m]) * (SC8 ? W8_INV : 1.0f); bf16_t* rowp = glu + (size_t)row * 512 + q * 128 + wc * 32 + 8 * fq;
                    f32x4 o0, o1;
#pragma unroll
                    for (int j = 0; j < 1; ++j) { o0 = (acc[ai][0][m][0] * r) * sigmoid_4(acc[ai][1][m][0] * r); o1 = (acc[ai][0][m][1] * r) * sigmoid_4(acc[ai][1][m][1] * r); }
                    *(u32x4*)rowp = pack8(o0, o1); }
        }
    }
};
typedef EpiEvenInT<false> EpiEvenIn;
template <bool SC8 = false> struct EpiOddInT {
    static constexpr bool PERM = true, AFTER_DRAIN = false, IDEM = true;
    PG8_NO_STATE
    bf16_t* gb; bf16_t* cv; const float* ssq;
    __device__ __forceinline__ void prefetch(const Unit& u, int wr, int wc, int fr, int fq, float (&pf)[8]) const { PG8_PF_ROWS(ssq, fq * SSQ_M + u.pm * BM + wr * 64 + fr); }
    __device__ __forceinline__ void operator()(const f32x4 (&acc)[2][2][4][2], const Unit& u, int wr, int wc, int fr, int fq, const float (&pf)[8], State& est) const {
        const int row0 = u.pm * BM + wr * 64 + fr;
        if (u.pn < 4) {
#pragma unroll
            for (int ai = 0; ai < 2; ++ai)
#pragma unroll
                for (int m = 0; m < 4; ++m) { const int row = row0 + ai * HALF + m * 16; const float r = rstd_pf(pf[ai * 4 + m]) * (SC8 ? W8_INV : 1.0f); bf16_t* rowp = gb + (size_t)row * 1024 + u.pn * 256 + wc * 32 + 8 * fq;
#pragma unroll
                    for (int bj = 0; bj < 2; ++bj) *(u32x4*)(rowp + bj * HALF) = pack8(acc[ai][bj][m][0] * r, acc[ai][bj][m][1] * r); }
        } else {
            const int q = u.pn - 4;
#pragma unroll
            for (int ai = 0; ai < 2; ++ai)
#pragma unroll
                for (int m = 0; m < 4; ++m) { const int row = row0 + ai * HALF + m * 16; const float r = rstd_pf(pf[ai * 4 + m]) * (SC8 ? W8_INV : 1.0f), r2 = r * r; bf16_t* rowp = cv + (size_t)row * 1024 + q * 128 + wc * 32 + 8 * fq;
                    *(u32x4*)rowp = pack8(acc[ai][0][m][0] * acc[ai][1][m][0] * r2, acc[ai][0][m][1] * acc[ai][1][m][1] * r2); }
        }
    }
};
typedef EpiOddInT<false> EpiOddIn;
template <bool DIRECT, bool OUT8, bool PUB = false> struct EpiGlu {
    static constexpr bool PERM = true, AFTER_DRAIN = false, IDEM = true;
    void* out; int ldo; const float* rs; float sc; PG8_LAS unsigned char* stg;
    static constexpr bool DEFER = OUT8 && !PUB && (GLU_DEFER_STORES != 0);
    struct State { u32x2 d[8]; int pm, pn; bool valid; };
    __device__ __forceinline__ void init(State& s) const { s.valid = false; s.pm = 0; s.pn = 0;
#pragma unroll
        for (int i = 0; i < 8; ++i) s.d[i] = (u32x2){0u, 0u}; }
    __device__ __forceinline__ void flush(State& s, int wr, int wc, int fr, int fq) const {
        if constexpr (DEFER) { if (s.valid) {
#pragma unroll
            for (int i = 0; i < 8; ++i) { const int row = s.pm * BM + wr * 64 + fr + (i >> 2) * HALF + (i & 3) * 16; *(u32x2*)((unsigned char*)out + (size_t)row * ldo + s.pn * 128 + wc * 32 + 8 * fq) = s.d[i]; }
            s.valid = false; } } }
    __device__ __forceinline__ void prefetch(const Unit& u, int wr, int wc, int fr, int fq, float (&pf)[8]) const { PG8_PF_ROWS(rs, (DIRECT ? 0 : fq * SSQ_M) + u.pm * BM + wr * 64 + fr); }
    __device__ __forceinline__ void glu8(const f32x4 (&acc)[2][2][4][2], int ai, int m, float r, f32x4& o0, f32x4& o1) const {
        const float rl = r * -1.4426950408889634f, q = __builtin_amdgcn_rcpf(r * r);
        const f32x4 d0 = exp2_4(acc[ai][0][m][0] * rl) * q + q, d1 = exp2_4(acc[ai][0][m][1] * rl) * q + q;
        o0 = (acc[ai][0][m][0] * acc[ai][1][m][0]) * rcp_4(d0); o1 = (acc[ai][0][m][1] * acc[ai][1][m][1]) * rcp_4(d1); }
    __device__ __forceinline__ void probe_math(const f32x4 (&acc)[2][2][4][2], const float (&pf)[8]) const {
#pragma unroll
        for (int ai = 0; ai < 2; ++ai)
#pragma unroll
            for (int m = 0; m < 4; ++m) { const float r = (DIRECT ? pf[ai * 4 + m] : rstd_pf(pf[ai * 4 + m])) * sc; f32x4 o0, o1; glu8(acc, ai, m, r, o0, o1);
                if constexpr (OUT8) { const u32x2 w = pack8_fp8(o0, o1); asm volatile("" :: "v"(w.x), "v"(w.y)); } else { const u32x4 w = pack8(o0, o1); asm volatile("" :: "v"(w.x), "v"(w.y), "v"(w.z), "v"(w.w)); } } }
    __device__ __forceinline__ void operator()(const f32x4 (&acc)[2][2][4][2], const Unit& u, int wr, int wc, int fr, int fq, const float (&pf)[8], State& est) const {
        const int row0 = u.pm * BM + wr * 64 + fr;
        if constexpr (PUB) {
#pragma unroll
            for (int ai = 0; ai < 2; ++ai)
#pragma unroll
                for (int m = 0; m < 4; ++m) { const int row = row0 + ai * HALF + m * 16; const float r = (DIRECT ? pf[ai * 4 + m] : rstd_pf(pf[ai * 4 + m])) * sc; const size_t off = (size_t)row * ldo + u.pn * 128 + wc * 32 + 8 * fq;
                    f32x4 o0, o1; glu8(acc, ai, m, r, o0, o1); const u32x2 w = pack8_fp8(o0, o1);
                    __hip_atomic_store((unsigned long long*)((unsigned char*)out + off), ((unsigned long long)w.y << 32) | w.x, __ATOMIC_RELAXED, __HIP_MEMORY_SCOPE_AGENT); }
        } else if constexpr (DEFER) {
            flush(est, wr, wc, fr, fq);
#pragma unroll
            for (int ai = 0; ai < 2; ++ai)
#pragma unroll
                for (int m = 0; m < 4; ++m) { const float r = (DIRECT ? pf[ai * 4 + m] : rstd_pf(pf[ai * 4 + m])) * sc; f32x4 o0, o1; glu8(acc, ai, m, r, o0, o1); est.d[ai * 4 + m] = pack8_fp8(o0, o1); }
            est.pm = u.pm; est.pn = u.pn; est.valid = true;
        } else if constexpr (OUT8 && (GLU_T21 != 0)) {
#pragma unroll
            for (int ai = 0; ai < 2; ++ai)
#pragma unroll
                for (int k = 0; k < 2; ++k) { u32x2 X, Y;
#pragma unroll
                    for (int q = 0; q < 4; ++q) { const int m = 2 * k + (q >> 1), n = q & 1; const float r = (DIRECT ? pf[ai * 4 + m] : rstd_pf(pf[ai * 4 + m])) * sc;
                        const f32x4 t = acc[ai][0][m][n] * r, o = (t * sigmoid_4(t)) * (acc[ai][1][m][n] * r);
                        int w = 0; w = __builtin_amdgcn_cvt_pk_fp8_f32(o[0], o[1], w, false); w = __builtin_amdgcn_cvt_pk_fp8_f32(o[2], o[3], w, true);
                        unsigned wu = (unsigned)w; asm volatile("" : "+v"(wu));
                        if (q == 0) X.x = wu; else if (q == 1) X.y = wu; else if (q == 2) Y.x = wu; else Y.y = wu; }
                    const auto s0 = __builtin_amdgcn_permlane16_swap(X.x, Y.x, false, false), s1 = __builtin_amdgcn_permlane16_swap(X.y, Y.y, false, false);
                    u32x4 w; w.x = s0[0]; w.y = s1[0]; w.z = s0[1]; w.w = s1[1];
                    const int row = row0 + ai * HALF + (2 * k + (fq & 1)) * 16;
                    *(u32x4*)((unsigned char*)out + (size_t)row * ldo + u.pn * 128 + wc * 32 + 16 * (fq >> 1)) = w; }
        } else if constexpr (!GLU_STAGE_STORES) {
#pragma unroll
            for (int ai = 0; ai < 2; ++ai)
#pragma unroll
                for (int m = 0; m < 4; ++m) { const int row = row0 + ai * HALF + m * 16; const float r = (DIRECT ? pf[ai * 4 + m] : rstd_pf(pf[ai * 4 + m])) * sc; const size_t off = (size_t)row * ldo + u.pn * 128 + wc * 32 + 8 * fq;
                    f32x4 o0, o1; glu8(acc, ai, m, r, o0, o1);
                    if constexpr (OUT8) st_out((u32x2*)((unsigned char*)out + off), pack8_fp8(o0, o1)); else st_out((u32x4*)((bf16_t*)out + off), pack8(o0, o1)); }
        } else if constexpr (OUT8) {
            const int w8 = wr * 4 + wc, l = fr + 16 * fq;
#pragma unroll
            for (int ai = 0; ai < 2; ++ai) {
#pragma unroll
                for (int m = 0; m < 4; ++m) { const float r = (DIRECT ? pf[ai * 4 + m] : rstd_pf(pf[ai * 4 + m])) * sc; f32x4 o0, o1; glu8(acc, ai, m, r, o0, o1);
                    *(PG8_LAS u32x2*)(stg + (wr * 64 + m * 16 + fr) * 144 + wc * 32 + 8 * fq) = pack8_fp8(o0, o1); }
                asm volatile("s_waitcnt lgkmcnt(0)" ::: "memory"); __builtin_amdgcn_s_barrier(); asm volatile("" ::: "memory");
#pragma unroll
                for (int t = 0; t < 2; ++t) { const int rl = 16 * w8 + 8 * t + (l >> 3), c = l & 7; const u32x4 v = *(const PG8_LAS u32x4*)(stg + rl * 144 + 16 * c);
                    *(u32x4*)((unsigned char*)out + (size_t)(u.pm * BM + ai * HALF + rl) * ldo + u.pn * 128 + 16 * c) = v; }
                asm volatile("s_waitcnt lgkmcnt(0)" ::: "memory"); __builtin_amdgcn_s_barrier(); asm volatile("" ::: "memory");
            }
        } else {
            const int w8 = wr * 4 + wc, l = fr + 16 * fq;
#pragma unroll
            for (int ai = 0; ai < 2; ++ai)
#pragma unroll
                for (int mh = 0; mh < 2; ++mh) {
#pragma unroll
                    for (int mm = 0; mm < 2; ++mm) { const int m = 2 * mh + mm; const float r = (DIRECT ? pf[ai * 4 + m] : rstd_pf(pf[ai * 4 + m])) * sc; f32x4 o0, o1; glu8(acc, ai, m, r, o0, o1);
                        *(PG8_LAS u32x4*)(stg + (wr * 32 + mm * 16 + fr) * 272 + wc * 64 + 16 * fq) = pack8(o0, o1); }
                    asm volatile("s_waitcnt lgkmcnt(0)" ::: "memory"); __builtin_amdgcn_s_barrier(); asm volatile("" ::: "memory");
#pragma unroll
                    for (int t = 0; t < 2; ++t) { const int rl = 8 * w8 + 4 * t + (l >> 4), c = l & 15; const u32x4 v = *(const PG8_LAS u32x4*)(stg + rl * 272 + 16 * c);
                        const int grow = u.pm * BM + ai * HALF + (rl >> 5) * 64 + mh * 32 + (rl & 31);
                        *(u32x4*)((bf16_t*)out + (size_t)grow * ldo + u.pn * 128 + 8 * c) = v; }
                    asm volatile("s_waitcnt lgkmcnt(0)" ::: "memory"); __builtin_amdgcn_s_barrier(); asm volatile("" ::: "memory");
                }
        }
    }
};
template <bool X8, bool SC8 = false> struct EpiRes {
    static constexpr bool PERM = true, AFTER_DRAIN = false, IDEM = false;
    PG8_NO_STATE
    bf16_t* xb; float* ssq_out; unsigned char* x8; PG8_LAS float* red;
    __device__ __forceinline__ void prefetch(const Unit&, int, int, int, int, float (&)[8]) const {}
    __device__ __forceinline__ void operator()(const f32x4 (&acc)[2][2][4][2], const Unit& u, int wr, int wc, int fr, int fq, const float (&pf)[8], State& est) const {
        const int row0 = u.pm * BM + wr * 64 + fr; bf16_t* const xb_ = xb; float* const so_ = ssq_out; constexpr float sc_ = SC8 ? W8_INV : 1.0f; unsigned char* const x8_ = x8; PG8_LAS float* const red_ = red;
#pragma unroll
        for (int ai = 0; ai < 2; ++ai)
#pragma unroll
            for (int m = 0; m < 4; ++m) { const int row = row0 + ai * HALF + m * 16; const size_t off = (size_t)row * 1024 + u.pn * 256 + wc * 32 + 8 * fq; bf16_t* rowp = xb_ + off; float s = 0.f;
#pragma unroll
                for (int bj = 0; bj < 2; ++bj) { const u32x4 old = *(const u32x4*)(rowp + bj * HALF); const f32x4 a0 = acc[ai][bj][m][0] * sc_, a1 = acc[ai][bj][m][1] * sc_;
                    f32x4 n0, n1; n0[0] = bf_lo(old.x) + a0[0]; n0[1] = bf_hi(old.x) + a0[1]; n0[2] = bf_lo(old.y) + a0[2]; n0[3] = bf_hi(old.y) + a0[3];
                    n1[0] = bf_lo(old.z) + a1[0]; n1[1] = bf_hi(old.z) + a1[1]; n1[2] = bf_lo(old.w) + a1[2]; n1[3] = bf_hi(old.w) + a1[3];
                    s += (n0[0] * n0[0] + n0[1] * n0[1]) + (n0[2] * n0[2] + n0[3] * n0[3]) + (n1[0] * n1[0] + n1[1] * n1[1]) + (n1[2] * n1[2] + n1[3] * n1[3]);
                    *(u32x4*)(rowp + bj * HALF) = pack8(n0, n1);
                    if constexpr (X8) *(u32x2*)(x8_ + off + bj * HALF) = pack8_fp8(n0, n1); }
                s = xor32_add(xor16_add(s));
                if (fq == 0) red_[(ai * HALF + wr * 64 + m * 16 + fr) * 4 + wc] = s; }
        asm volatile("s_waitcnt lgkmcnt(0)" ::: "memory"); __builtin_amdgcn_s_barrier(); asm volatile("" ::: "memory");
        { const int l = fr + 16 * fq; if (l < 32) { const int q = wc * 32 + l, rl = (q >> 6) * HALF + wr * 64 + (q & 63); const f32x4 v = *(const PG8_LAS f32x4*)(red_ + rl * 4);
            so_[(size_t)u.pn * SSQ_M + u.pm * BM + rl] = (v[0] + v[1]) + (v[2] + v[3]); } }
    }
};
template <class T> struct is_glu { static constexpr bool v = false; };
template <bool A, bool B, bool C> struct is_glu<EpiGlu<A, B, C>> { static constexpr bool v = true; };
constexpr float OG8_SCALE = 16.0f, OG8_INV = 1.0f / 16.0f;
template <bool OG8> struct EpiMoeDown {
    static constexpr bool PERM = true, AFTER_DRAIN = false, IDEM = true;
    PG8_NO_STATE
    void* og; const float* gate; float sc;
    __device__ __forceinline__ void prefetch(const Unit& u, int wr, int wc, int fr, int fq, float (&pf)[8]) const { PG8_PF_ROWS(gate, u.pm * BM + wr * 64 + fr); }
    __device__ __forceinline__ void operator()(const f32x4 (&acc)[2][2][4][2], const Unit& u, int wr, int wc, int fr, int fq, const float (&pf)[8], State& est) const {
        const int row0 = u.pm * BM + wr * 64 + fr;
#pragma unroll
        for (int ai = 0; ai < 2; ++ai)
#pragma unroll
            for (int m = 0; m < 4; ++m) { const int row = row0 + ai * HALF + m * 16; const float r = pf[ai * 4 + m] * sc * (OG8 ? OG8_SCALE : 1.0f); const size_t off = (size_t)row * 1024 + u.pn * 256 + wc * 32 + 8 * fq;
#pragma unroll
                for (int bj = 0; bj < 2; ++bj) { if constexpr (OG8) st_out((u32x2*)((unsigned char*)og + off + bj * HALF), pack8_fp8(acc[ai][bj][m][0] * r, acc[ai][bj][m][1] * r));
                                                else *(u32x4*)((bf16_t*)og + off + bj * HALF) = pack8(acc[ai][bj][m][0] * r, acc[ai][bj][m][1] * r); } }
    }
};

template <class Epi, class Sched, bool ALIGN_EPI = false, bool SP2 = false, bool F8 = false, bool FK = false>
__device__ __forceinline__ void gemm_phase(PG8_LAS unsigned char* lds, const Gemm g, const Sched& S, const Epi& E) {
    int tid_ = threadIdx.x; asm volatile("" : "+v"(tid_));
    const int tid = tid_, wid = __builtin_amdgcn_readfirstlane(tid >> 6), lane = tid & 63, wr = wid >> 2, wc = wid & 3, fr = lane & 15, fq = lane >> 4;
    constexpr bool BF16_ASM = (GEMM_BF16_ASM != 0);
    constexpr bool ZERO_C = (GEMM_ZERO_C != 0) && (F8 || BF16_ASM);
    const int K = F8 ? g.K / 2 : g.K, nt = K / BK;
    unsigned voffA[2], voffB[2];
#pragma unroll
    for (int i = 0; i < 2; ++i) { int R, C; stage_rc(tid * 16 + i * 8192, R, C); const int Rb = Epi::PERM ? ((R & ~31) + perm32(R & 31)) : R;
        voffA[i] = (unsigned)(R * K + C) * 2u; voffB[i] = (unsigned)(Rb * K + C) * 2u; }
    constexpr bool fk = FK;
    const size_t kstep = fk ? (size_t)0 : (size_t)(BK * 2);
    const size_t hstep = (size_t)HALF * K * 2;
    const size_t tstep = 2 * hstep;
    const unsigned ldsw = (unsigned)wid * 1024u;
    const int aoff = lds_byte(wr * 64 + fr, fq * 8), boff = lds_byte(wc * 32 + fr, fq * 8);
#define PG8_SA(b, h) (((b) * 2 + (h)) * HTB)
#define PG8_SB(b, h) ((4 + (b) * 2 + (h)) * HTB)
#ifndef PROBE_FKMODE
#define PROBE_FKMODE 0
#endif
#define PG8_STAGE(bufoff, gbase, voff) do { if constexpr (!(FK && PROBE_FKMODE >= 2)) _Pragma("unroll") for (int _i = 0; _i < 2; ++_i) \
        __builtin_amdgcn_global_load_lds((const unsigned*)((const char*)(gbase) + (voff)[_i]), (PG8_LAS unsigned*)(lds + (bufoff) + ldsw + _i * 8192), 16, 0, 0); } while (0)
#define PG8_LD16(off) (*(const PG8_LAS v4i32*)(lds + (off)))
#define PG8_LDA(dst, b, h) do { if constexpr (FK && PROBE_FKMODE == 3) { } else if constexpr (F8) { _Pragma("unroll") for (int m = 0; m < 4; ++m) dst##8[m] = __builtin_shufflevector(PG8_LD16(PG8_SA(b, h) + aoff + m * 2048), PG8_LD16(PG8_SA(b, h) + aoff + m * 2048 + 1024), 0, 1, 2, 3, 4, 5, 6, 7); } \
        else { _Pragma("unroll") for (int m = 0; m < 4; ++m) _Pragma("unroll") for (int k = 0; k < 2; ++k) dst[m][k] = *(const PG8_LAS bf16x8*)(lds + PG8_SA(b, h) + aoff + m * 2048 + k * 1024); } } while (0)
#define PG8_LDB(dst, b, h) do { if constexpr (FK && PROBE_FKMODE == 3) { } else if constexpr (F8) { _Pragma("unroll") for (int n = 0; n < 2; ++n) dst##8[n] = __builtin_shufflevector(PG8_LD16(PG8_SB(b, h) + boff + n * 2048), PG8_LD16(PG8_SB(b, h) + boff + n * 2048 + 1024), 0, 1, 2, 3, 4, 5, 6, 7); } \
        else { _Pragma("unroll") for (int n = 0; n < 2; ++n) _Pragma("unroll") for (int k = 0; k < 2; ++k) dst[n][k] = *(const PG8_LAS bf16x8*)(lds + PG8_SB(b, h) + boff + n * 2048 + k * 1024); } } while (0)
#define PG8_MMA(ai, bj, At, Bt) do { if constexpr (GEMM_PRIO != 0) __builtin_amdgcn_s_setprio(1); \
        if constexpr (FK && PROBE_FKMODE == 4) { } else if constexpr (F8) { _Pragma("unroll") for (int m = 0; m < 4; ++m) _Pragma("unroll") for (int n = 0; n < 2; ++n) \
            asm volatile("v_mfma_f32_16x16x128_f8f6f4 %0, %1, %2, %0" : "+v"(acc[ai][bj][m][n]) : "v"(Bt##8[n]), "v"(At##8[m])); } \
        else { _Pragma("unroll") for (int m = 0; m < 4; ++m) _Pragma("unroll") for (int n = 0; n < 2; ++n) _Pragma("unroll") for (int k = 0; k < 2; ++k) \
            { if constexpr (BF16_ASM) asm volatile("v_mfma_f32_16x16x32_bf16 %0, %1, %2, %0" : "+v"(acc[ai][bj][m][n]) : "v"(Bt[n][k]), "v"(At[m][k])); else acc[ai][bj][m][n] = __builtin_amdgcn_mfma_f32_16x16x32_bf16(Bt[n][k], At[m][k], acc[ai][bj][m][n], 0, 0, 0); } } \
        if constexpr (GEMM_PRIO != 0) __builtin_amdgcn_s_setprio(0); } while (0)
#define PG8_MMAZ(ai, bj, At, Bt) do { if constexpr (!ZERO_C) { PG8_MMA(ai, bj, At, Bt); } else if (t != 0) { PG8_MMA(ai, bj, At, Bt); } else { if constexpr (GEMM_PRIO != 0) __builtin_amdgcn_s_setprio(1); \
        if constexpr (FK && PROBE_FKMODE == 4) { } else if constexpr (F8) { _Pragma("unroll") for (int m = 0; m < 4; ++m) _Pragma("unroll") for (int n = 0; n < 2; ++n) \
            asm volatile("v_mfma_f32_16x16x128_f8f6f4 %0, %1, %2, 0" : "=v"(acc[ai][bj][m][n]) : "v"(Bt##8[n]), "v"(At##8[m])); } \
        else { _Pragma("unroll") for (int m = 0; m < 4; ++m) _Pragma("unroll") for (int n = 0; n < 2; ++n) { \
            asm volatile("v_mfma_f32_16x16x32_bf16 %0, %1, %2, 0" : "=v"(acc[ai][bj][m][n]) : "v"(Bt[n][0]), "v"(At[m][0])); \
            asm volatile("v_mfma_f32_16x16x32_bf16 %0, %1, %2, %0" : "+v"(acc[ai][bj][m][n]) : "v"(Bt[n][1]), "v"(At[m][1])); } } \
        if constexpr (GEMM_PRIO != 0) __builtin_amdgcn_s_setprio(0); } } while (0)
#define PG8_RPRIO(p) do { if constexpr (GEMM_PRIO == 2) __builtin_amdgcn_s_setprio(p); } while (0)
#define PG8_WAIT_V(n) do { if constexpr (!(FK && PROBE_FKMODE >= 1)) asm volatile("s_waitcnt vmcnt(" #n ")" ::: "memory"); } while (0)
#define PG8_WAIT_L(n) asm volatile("s_waitcnt lgkmcnt(" #n ")" ::: "memory")
#define PG8_BAR __builtin_amdgcn_s_barrier()
#define PG8_SCHED __builtin_amdgcn_sched_barrier(0)
    Unit cur, nxt; int ui = 0;
    if (!S.next(0, cur)) return;
    f32x4 acc[2][2][4][2];
#pragma unroll
    for (int a = 0; a < 2; ++a)
#pragma unroll
        for (int b = 0; b < 2; ++b)
#pragma unroll
            for (int m = 0; m < 4; ++m)
#pragma unroll
                for (int n = 0; n < 2; ++n) { if constexpr (!ZERO_C || (FK && PROBE_FKMODE == 4)) acc[a][b][m][n] = (f32x4){0.f, 0.f, 0.f, 0.f}; }
    typename Epi::State est; E.init(est);
    int pend_pm = -1;
    float pf[8] = {0.f, 0.f, 0.f, 0.f, 0.f, 0.f, 0.f, 0.f};
    bf16x8 At[4][2], B0[2][2], B1[2][2]; v8i32 At8[4], B08[2], B18[2];
    if constexpr (FK && PROBE_FKMODE == 3) {
#pragma unroll
        for (int m = 0; m < 4; ++m) { asm volatile("" : "=v"(At8[m])); asm volatile("" : "=v"(At[m][0])); asm volatile("" : "=v"(At[m][1])); }
#pragma unroll
        for (int n = 0; n < 2; ++n) { asm volatile("" : "=v"(B08[n])); asm volatile("" : "=v"(B18[n])); asm volatile("" : "=v"(B0[n][0])); asm volatile("" : "=v"(B0[n][1])); asm volatile("" : "=v"(B1[n][0])); asm volatile("" : "=v"(B1[n][1])); }
    }
    const char* cA = (const char*)g.A + (fk ? (size_t)0 : (size_t)cur.pm * tstep); const char* cB = (const char*)g.Bt + (fk ? (size_t)0 : S.b_off(cur) + (size_t)cur.pn * tstep);
    S.a_ready(cur);
    if constexpr (SP2) {
        PG8_STAGE(PG8_SB(0, 0), cB, voffB); PG8_STAGE(PG8_SB(0, 1), cB + hstep, voffB); PG8_STAGE(PG8_SA(0, 0), cA, voffA); PG8_STAGE(PG8_SA(0, 1), cA + hstep, voffA);
        if (wr == 1) PG8_BAR;
        PG8_WAIT_V(2); PG8_BAR;
        PG8_STAGE(PG8_SB(1, 0), cB + kstep, voffB); PG8_STAGE(PG8_SA(1, 0), cA + kstep, voffA); PG8_STAGE(PG8_SB(1, 1), cB + hstep + kstep, voffB);
        PG8_WAIT_V(6); PG8_BAR;
    } else {
        PG8_STAGE(PG8_SB(0, 0), cB, voffB); PG8_STAGE(PG8_SA(0, 0), cA, voffA); PG8_STAGE(PG8_SB(0, 1), cB + hstep, voffB); PG8_STAGE(PG8_SA(0, 1), cA + hstep, voffA);
        if (wr == 1) PG8_BAR;
        PG8_WAIT_V(4); PG8_BAR;
        PG8_STAGE(PG8_SB(1, 0), cB + kstep, voffB); PG8_STAGE(PG8_SA(1, 0), cA + kstep, voffA); PG8_STAGE(PG8_SB(1, 1), cB + hstep + kstep, voffB);
        PG8_WAIT_V(6); PG8_BAR;
    }
    for (;;) {
        const bool has_next = S.next(ui + 1, nxt);
        const char* nA = (has_next && !fk) ? (const char*)g.A + (size_t)nxt.pm * tstep : cA; const char* nB = (has_next && !fk) ? (const char*)g.Bt + S.b_off(nxt) + (size_t)nxt.pn * tstep : cB;
        for (int t = 0; t < nt; t += 2) {
            const bool last = (t == nt - 2);
            const char* a1 = cA + (size_t)(t + 1) * kstep;
            const char* a2 = last ? nA : cA + (size_t)(t + 2) * kstep; const char* b2 = last ? nB : cB + (size_t)(t + 2) * kstep;
            const char* a3 = a2 + kstep; const char* b3 = b2 + kstep;
            if (last) { E.prefetch(cur, wr, wc, fr, fq, pf); if constexpr (Sched::PUBD) { if (pend_pm >= 0) { S.publish(pend_pm); pend_pm = -1; } } }
            if (last && has_next) S.a_ready(nxt);
            if constexpr (SP2) {
            PG8_RPRIO(2); PG8_LDB(B0, 0, 0); PG8_LDB(B1, 0, 1); PG8_SCHED; PG8_LDA(At, 0, 0); PG8_RPRIO(0); PG8_STAGE(PG8_SA(1, 1), a1 + hstep, voffA);
            PG8_WAIT_V(8); PG8_WAIT_L(0); PG8_BAR; PG8_MMAZ(0, 0, At, B0); PG8_MMAZ(0, 1, At, B1); PG8_BAR; PG8_SCHED;
            PG8_RPRIO(2); PG8_LDA(At, 0, 1); PG8_RPRIO(0); PG8_STAGE(PG8_SB(0, 0), b2, voffB); PG8_STAGE(PG8_SB(0, 1), b2 + hstep, voffB); PG8_STAGE(PG8_SA(0, 0), a2, voffA);
            PG8_WAIT_V(8); PG8_WAIT_L(0); PG8_BAR; PG8_MMAZ(1, 0, At, B0); PG8_MMAZ(1, 1, At, B1); PG8_BAR; PG8_SCHED;
            PG8_RPRIO(2); PG8_LDB(B0, 1, 0); PG8_LDB(B1, 1, 1); PG8_SCHED; PG8_LDA(At, 1, 0); PG8_RPRIO(0); PG8_STAGE(PG8_SA(0, 1), a2 + hstep, voffA);
            PG8_WAIT_V(8); PG8_WAIT_L(0); PG8_BAR; PG8_MMA(0, 0, At, B0); PG8_MMA(0, 1, At, B1); PG8_BAR; PG8_SCHED;
            PG8_RPRIO(2); PG8_LDA(At, 1, 1); PG8_RPRIO(0); PG8_STAGE(PG8_SB(1, 0), b3, voffB); PG8_STAGE(PG8_SB(1, 1), b3 + hstep, voffB); PG8_STAGE(PG8_SA(1, 0), a3, voffA);
            PG8_WAIT_V(8); PG8_WAIT_L(0); PG8_BAR; PG8_MMA(1, 0, At, B0); PG8_MMA(1, 1, At, B1); PG8_BAR; PG8_SCHED;
            } else {
            PG8_LDB(B0, 0, 0); PG8_SCHED; PG8_LDA(At, 0, 0); PG8_STAGE(PG8_SA(1, 1), a1 + hstep, voffA);
            PG8_WAIT_L(8); PG8_BAR; PG8_WAIT_L(0); PG8_MMAZ(0, 0, At, B0); PG8_BAR; PG8_SCHED;
            PG8_LDB(B1, 0, 1); PG8_STAGE(PG8_SB(0, 0), b2, voffB);
            PG8_BAR; PG8_WAIT_L(0); PG8_MMAZ(0, 1, At, B1); PG8_BAR;
            PG8_LDA(At, 0, 1); PG8_STAGE(PG8_SA(0, 0), a2, voffA);
            PG8_BAR; PG8_WAIT_L(0); PG8_MMAZ(1, 0, At, B0); PG8_BAR; PG8_SCHED;
            PG8_STAGE(PG8_SB(0, 1), b2 + hstep, voffB);
            PG8_WAIT_V(6); PG8_BAR; PG8_MMAZ(1, 1, At, B1); PG8_BAR;
            PG8_LDB(B0, 1, 0); PG8_SCHED; PG8_LDA(At, 1, 0); PG8_STAGE(PG8_SA(0, 1), a2 + hstep, voffA);
            PG8_WAIT_L(8); PG8_BAR; PG8_WAIT_L(0); PG8_MMA(0, 0, At, B0); PG8_BAR; PG8_SCHED;
            PG8_LDB(B1, 1, 1); PG8_STAGE(PG8_SB(1, 0), b3, voffB);
            PG8_BAR; PG8_WAIT_L(0); PG8_MMA(0, 1, At, B1); PG8_BAR;
            PG8_LDA(At, 1, 1); PG8_STAGE(PG8_SA(1, 0), a3, voffA);
            PG8_BAR; PG8_WAIT_L(0); PG8_MMA(1, 0, At, B0); PG8_BAR; PG8_SCHED;
            PG8_STAGE(PG8_SB(1, 1), b3 + hstep, voffB);
            PG8_WAIT_V(6); PG8_BAR; PG8_MMA(1, 1, At, B1); PG8_BAR;
            }
        }
        if constexpr (ALIGN_EPI) { if (wr == 0) PG8_BAR; }
        if constexpr (F8 || BF16_ASM) {
#define PG8_A4(a, b) "+v"(acc[a][b][0][0]), "+v"(acc[a][b][0][1]), "+v"(acc[a][b][1][0]), "+v"(acc[a][b][1][1]), "+v"(acc[a][b][2][0]), "+v"(acc[a][b][2][1]), "+v"(acc[a][b][3][0]), "+v"(acc[a][b][3][1])
            asm volatile("s_nop 15\n\ts_nop 7" : PG8_A4(0, 0), PG8_A4(0, 1));
            asm volatile("" : PG8_A4(1, 0), PG8_A4(1, 1));
#undef PG8_A4
        }
        if constexpr (!Epi::AFTER_DRAIN) { E(acc, cur, wr, wc, fr, fq, pf, est);
#ifdef EPI_TWICE_GLU
            if constexpr (is_glu<Epi>::v) { asm volatile("" ::: "memory"); if constexpr (EPI_TWICE_GLU == 2) E.probe_math(acc, pf); else E(acc, cur, wr, wc, fr, fq, pf, est); }
#endif
#ifdef EPI_TWICE
            if constexpr (Epi::IDEM) { asm volatile("" ::: "memory"); E(acc, cur, wr, wc, fr, fq, pf, est); }
#endif
            if constexpr (Sched::PUBD) pend_pm = cur.pm; else S.done(cur); }
#ifdef EPI_SLEEP
        if constexpr (Epi::IDEM) __builtin_amdgcn_s_sleep(EPI_SLEEP);
#endif
        if (!has_next) break;
#pragma unroll
        for (int a = 0; a < 2; ++a)
#pragma unroll
            for (int b = 0; b < 2; ++b)
#pragma unroll
                for (int m = 0; m < 4; ++m)
#pragma unroll
                    for (int n = 0; n < 2; ++n) { if constexpr (!ZERO_C) acc[a][b][m][n] = (f32x4){0.f, 0.f, 0.f, 0.f}; }
        cur = nxt; cA = nA; cB = nB; ++ui;
        if constexpr (ALIGN_EPI) { if (wr == 1) PG8_BAR; }
    }
    E.flush(est, wr, wc, fr, fq);
    asm volatile("s_waitcnt vmcnt(0)" ::: "memory"); if constexpr (Sched::PUBD) { if (pend_pm >= 0) S.publish(pend_pm); }
    if constexpr (!ALIGN_EPI) { if (wr == 0) PG8_BAR; }
    PG8_BAR;
    if constexpr (Epi::AFTER_DRAIN) { E.fused(acc, cur, wr, wc, fr, fq, lds, wid, lane); S.done(cur); }
#undef PG8_SA
#undef PG8_SB
#undef PG8_STAGE
#undef PG8_LD16
#undef PG8_LDA
#undef PG8_LDB
#undef PG8_MMA
#undef PG8_MMAZ
#undef PG8_WAIT_V
#undef PG8_WAIT_L
#undef PG8_BAR
#undef PG8_SCHED
#undef PG8_RPRIO
}
}

constexpr int NWAVES = 8;
#ifndef MK_PER_PHASE
#define MK_PER_PHASE 0
#endif
#ifndef MOE_FP8
#define MOE_FP8 1
#endif
#ifndef FFN2_FP8
#define FFN2_FP8 1
#endif
#ifndef FILL_TAILS
#define FILL_TAILS 1
#endif
#ifndef EPI_ALIGN_HEAVY
#define EPI_ALIGN_HEAVY true
#endif
#ifndef F8_SP2
#define F8_SP2 true
#endif
#ifndef WGM_E1
#define WGM_E1 2
#endif
#ifndef WGM_E4
#define WGM_E4 2
#endif
#ifndef WGM_O1
#define WGM_O1 2
#endif
#ifndef WGM_O6
#define WGM_O6 2
#endif
#ifndef WGM_O7
#define WGM_O7 2
#endif
#ifndef WGM_N4
#define WGM_N4 8
#endif
#ifndef MOE_CHAIN
#define MOE_CHAIN 0
#endif
#ifndef STAGGER
#define STAGGER 0
#endif
#ifndef MOE_OG8
#define MOE_OG8 (MOE_FP8)
#endif
#ifndef XCD_STAGGER
#define XCD_STAGGER 0
#endif
#ifndef FILL_N_E4
#define FILL_N_E4 5
#endif
#ifndef FILL_N_O7
#define FILL_N_O7 6
#endif
#ifndef DOWN8_L0
#define DOWN8_L0 1
#endif
#ifndef MIX8_L3
#define MIX8_L3 1
#endif
#ifndef MIX8IN_L2
#define MIX8IN_L2 1
#endif
#ifndef MIX8OUT_L2
#define MIX8OUT_L2 0
#endif
#ifndef GLU_WT
#define GLU_WT 0
#endif
#ifndef MK_LAST_PHASE
#define MK_LAST_PHASE 26
#endif

constexpr int M = 16384, D = 1024, SEQ = 8192, DFF = 2816, NE = 8, NFF2 = 2 * DFF;
constexpr int EV_IN = 2048, OD_IN = 3072, AW = 512, BW = 512, CHUNK = 128, KB = 31;
constexpr int MAXP = 136, MSLOT = MAXP * 256;
constexpr float LN_EPS = 1e-5f;
constexpr int NPHASE = 27;

constexpr size_t MiB = 1u << 20;
constexpr size_t WS_CTL = 0, CTL_ZERO_BYTES = 128 * 1024;
constexpr size_t WS_MISC = 2 * MiB;
constexpr size_t MI_RT = 0, MI_WSB = 64 * 1024, MI_TOKE = 512 * 1024, MI_TOKG = 640 * 1024, MI_TOKR = 768 * 1024, MI_TOKS = 896 * 1024,
                 MI_CNT = 1024 * 1024, MI_LNA = 2048 * 1024  , MI_TOKRS = 1472 * 1024, MI_HDR = 1040 * 1024, MI_RSG = 1088 * 1024, MI_GTG = 1280 * 1024;
constexpr size_t WS_SSQ = 6 * MiB;
constexpr size_t WS_WEV = 14 * MiB, EV_BYTES = 23 * MiB;
constexpr size_t EVO_WIN = 0, EVO_WOUT = 4 * MiB, EVO_W13 = 6 * MiB, EVO_W2 = 17 * MiB;
constexpr size_t WS_WOD = WS_WEV + 2 * EV_BYTES, OD_BYTES = 140 * MiB;
constexpr size_t ODO_WIN = 0, ODO_WOUT = 6 * MiB, ODO_W13 = 8 * MiB, ODO_W2 = 96 * MiB;
constexpr size_t WS_XB = WS_WOD + 2 * OD_BYTES;
constexpr size_t WS_R1 = WS_XB + 32 * MiB;
constexpr size_t WS_R2 = WS_R1 + 68 * MiB;
constexpr size_t WS_R3 = WS_R2 + 68 * MiB;
constexpr size_t WS_END = WS_R3 + 187 * MiB;
constexpr size_t WS_GLU_OFF = 160 * MiB;
static_assert((size_t)MSLOT * D * 2 <= 68 * MiB && (size_t)MSLOT * DFF * 2 <= 187 * MiB && (size_t)M * DFF * 2 <= 187 * MiB, "d_ws map");
constexpr int CW_TMO = 0, CW_CODE = 1;
constexpr int CW_FILL = 2048;
constexpr int CW_PCNT = 8192, PCNT_WORDS = 136 * 64;
constexpr int CW_BAR = 4096;

constexpr int RING_BYTES = 131072;
constexpr int LDS_BYTES = 147456;
constexpr int STG_OFF = RING_BYTES;
constexpr int RED_OFF = RING_BYTES;
constexpr int PTAB_OFF = LDS_BYTES - 2048;
constexpr int MISC_OFF = LDS_BYTES - 512;

#define GAS __attribute__((address_space(1)))
#define LAS __attribute__((address_space(3)))
typedef unsigned short bf16;
typedef unsigned v4u __attribute__((ext_vector_type(4)));
typedef unsigned v2u __attribute__((ext_vector_type(2)));
typedef float f32x4 __attribute__((ext_vector_type(4)));
typedef float f32x2 __attribute__((ext_vector_type(2)));
typedef short bf16x8 __attribute__((ext_vector_type(8)));
typedef GAS unsigned gu32;
#define RLX_AGENT __ATOMIC_RELAXED, __HIP_MEMORY_SCOPE_AGENT
#define LDS_WAIT() asm volatile("s_waitcnt lgkmcnt(0)" ::: "memory")
#define VM_WAIT() asm volatile("s_waitcnt vmcnt(0)" ::: "memory")
using pg8::cvt_pk_bf16; using pg8::bf_lo; using pg8::bf_hi; using pg8::sigmoidf_fast; using pg8::siluf_fast; using pg8::RMS_EPS;

#define XB_TMO      128
#define XB_XCNT(j)  (256  + 64 * (j))
#define XB_XSUB(j)  (1280 + 64 * (j))
#define XB_XGEN(j)  (2304 + 64 * (j))
#define XB_TOP      3328
#define XB_TOPGEN   3392
#define XCD_BAR_WORDS 3456
#define XB_SPIN_CAP (1u << 18)
#define XB_LSUB(j)  (3456 + 16 * (j))
#define XB_LGEN(j)  (3712 + 16 * (j))
#define XB_MISM     3968
#ifndef LOCAL_BAR
#define LOCAL_BAR 1
#endif

__device__ __forceinline__ unsigned xb_ld(unsigned* p)              { return __hip_atomic_load(p, __ATOMIC_RELAXED, __HIP_MEMORY_SCOPE_AGENT); }
__device__ __forceinline__ unsigned xb_add(unsigned* p, unsigned v) { return __hip_atomic_fetch_add(p, v, __ATOMIC_RELAXED, __HIP_MEMORY_SCOPE_AGENT); }
__device__ __forceinline__ unsigned xb_xcc_id() { return (unsigned)__builtin_amdgcn_s_getreg((3 << 11) | 20) & 0xFu; }
#define XB_SPIN(cond, bar) do { unsigned _sp = 0; while (cond) { __builtin_amdgcn_s_sleep(1); \
    if ((++_sp & 255u) == 0u) { if (xb_ld(&(bar)[XB_TMO])) break; if (_sp > XB_SPIN_CAP) { atomicAdd(&(bar)[XB_TMO], 1u); break; } } } } while (0)

struct XcdBarrier {
    unsigned* bar; unsigned x;
    volatile LAS unsigned* st;
};

__device__ __forceinline__ XcdBarrier xcd_barrier_post(unsigned* bar, volatile LAS unsigned* st) {
    XcdBarrier b; b.bar = bar; b.x = xb_xcc_id(); b.st = st;
    if (threadIdx.x == 0) { (void)xb_add(&bar[XB_XCNT(b.x)], 1u); if (b.x != (blockIdx.x & 7u)) (void)xb_add(&bar[XB_MISM], 1u); }
    return b;
}
__device__ __forceinline__ void xcd_barrier_complete(unsigned* bar, unsigned x, unsigned& nloc, unsigned& nx, unsigned& even) {
    const unsigned G = gridDim.x * gridDim.y * gridDim.z;
    unsigned sum, cnt, mine, sp = 0u, ev;
    for (;;) {
        sum = 0u; cnt = 0u; mine = 0u; ev = 1u;
#pragma unroll
        for (unsigned j = 0; j < 16; ++j) { const unsigned c = xb_ld(&bar[XB_XCNT(j)]); sum += c; cnt += (c > 0u) ? 1u : 0u; mine = (j == x) ? c : mine; ev = (c > 0u && c * 8u != G) ? 0u : ev; }
        if (sum == G) break;
        __builtin_amdgcn_s_sleep(1);
        if ((++sp & 255u) == 0u) { if (xb_ld(&bar[XB_TMO])) break; if (sp > XB_SPIN_CAP) { atomicAdd(&bar[XB_TMO], 1u); break; } }
    }
    nloc = mine > 0u ? mine : 1u; nx = cnt > 0u ? cnt : 1u; even = (sum == G) ? ev : 0u;
}

__device__ __forceinline__ void xcd_barrier(const XcdBarrier& b) {
    asm volatile("s_waitcnt vmcnt(0)" ::: "memory");
    __syncthreads();
    if (threadIdx.x == 0) {
        unsigned* bar = b.bar;
        __builtin_amdgcn_s_waitcnt(0);
        unsigned nloc = b.st[0], nx = b.st[1];
        const bool first_ = (nloc == 0u);
        unsigned even_ = 0u;
        if (nloc == 0u) { xcd_barrier_complete(bar, b.x, nloc, nx, even_); b.st[0] = nloc; b.st[1] = nx; }
        const unsigned old = xb_add(&bar[XB_XSUB(b.x)], 1u);
        const unsigned gen = old / nloc;
        if (old + 1u == (gen + 1u) * nloc) {
            __builtin_amdgcn_fence(__ATOMIC_RELEASE, "agent");
            asm volatile("s_waitcnt vmcnt(0)" ::: "memory");
            const unsigned og = xb_add(&bar[XB_TOP], 1u);
            const unsigned tg = og / nx;
            if (og + 1u == (tg + 1u) * nx) xb_add(&bar[XB_TOPGEN], 1u);
            else XB_SPIN(xb_ld(&bar[XB_TOPGEN]) == tg, bar);
            __builtin_amdgcn_fence(__ATOMIC_ACQUIRE, "agent");
            xb_add(&bar[XB_XGEN(b.x)], 1u);
            asm volatile("s_waitcnt vmcnt(0)" ::: "memory");
        } else {
            XB_SPIN(xb_ld(&bar[XB_XGEN(b.x)]) == gen, bar);
            __builtin_amdgcn_fence(__ATOMIC_ACQUIRE, "agent");
            asm volatile("s_waitcnt vmcnt(0)" ::: "memory");
        }
        if (first_) {
            const unsigned G_ = gridDim.x; b.st[2] = (LOCAL_BAR != 0 && even_ != 0u && nx == 8u && G_ == 256u && xb_ld(&bar[XB_MISM]) == 0u) ? 1u : 0u; }
    }
    __syncthreads();
}
__device__ __forceinline__ void xcd_local_barrier(const XcdBarrier& b) {
    asm volatile("s_waitcnt vmcnt(0)" ::: "memory");
    __syncthreads();
    if (threadIdx.x == 0) {
        unsigned* bar = b.bar;
        __builtin_amdgcn_s_waitcnt(0);
        const unsigned nloc = b.st[0];
        const unsigned old = xb_add(&bar[XB_LSUB(b.x)], 1u);
        const unsigned gen = old / nloc;
        if (old + 1u == (gen + 1u) * nloc) xb_add(&bar[XB_LGEN(b.x)], 1u);
        else XB_SPIN(xb_ld(&bar[XB_LGEN(b.x)]) == gen, bar);
        __builtin_amdgcn_fence(__ATOMIC_ACQUIRE, "agent");
        asm volatile("s_waitcnt vmcnt(0)" ::: "memory");
    }
    __syncthreads();
}

typedef const float* fptr_t;
typedef __attribute__((address_space(4))) const fptr_t* intab_t;
struct Frame {
    LAS unsigned char* lds;
    volatile LAS unsigned* MISC;
    GAS unsigned char* ws;
    int tid, lane, wave;
    int vcu, G;
    intab_t in;
};
__device__ __forceinline__ float wave_sum(float v) { return pg8::wave_sum_valu(v); }
template <int N, int SZ, int OFF> __device__ __forceinline__ void reduce_scatter_step(float (&v)[SZ], int lane) {
#pragma unroll
    for (int i = 0; i < N / 2; ++i) { const bool hi = (lane & OFF) != 0; const float keep = hi ? v[i + N / 2] : v[i], send = hi ? v[i] : v[i + N / 2]; v[i] = keep + pg8::xor_get<OFF>(send, lane); }
}
__device__ __forceinline__ int opaque_v(int x) { asm volatile("" : "+v"(x)); return x; }
__device__ __forceinline__ int opaque_s(int x) { asm volatile("" : "+s"(x)); return x; }
__device__ __forceinline__ intab_t opaque_tab(intab_t p) { asm volatile("" : "+s"(p)); return p; }
__device__ __forceinline__ bf16* ev_w(Frame& F, int lp, size_t off) { return (bf16*)(F.ws + WS_WEV + (size_t)lp * EV_BYTES + off); }
__device__ __forceinline__ bf16* od_w(Frame& F, int lp, size_t off) { return (bf16*)(F.ws + WS_WOD + (size_t)lp * OD_BYTES + off); }
__device__ __forceinline__ bf16* ev_wl(GAS unsigned char* ws, int lp, size_t off) { return (bf16*)(ws + WS_WEV + (size_t)lp * EV_BYTES + off); }
__device__ __forceinline__ bf16* od_wl(GAS unsigned char* ws, int lp, size_t off) { return (bf16*)(ws + WS_WOD + (size_t)lp * OD_BYTES + off); }
__device__ __forceinline__ float* ssq_arr(Frame& F, int s) { return (float*)(F.ws + WS_SSQ) + (size_t)s * 4 * M; }
__device__ __forceinline__ float rstd_wave(const float* part, int row, int lane) { float s = (lane < 4) ? part[(size_t)lane * M + row] : 0.f; s = wave_sum(s); return __builtin_amdgcn_rsqf(s * (1.0f / 1024.0f) + RMS_EPS); }
__device__ __forceinline__ void ssq_store_row(float* part, int row, int lane, float s) { if (lane < 4) part[(size_t)lane * M + row] = (lane == 0) ? s : 0.f; }

__device__ __forceinline__ int p0_drow(int mode, int which, int n0) {
    if (mode == 0) return n0;
    if (mode == 1) return (n0 >> 7) * 256 + which * 128 + (n0 & 127);
    if (n0 < 1024) return n0;
    const int m = n0 - 1024, half = (mode == 2) ? 512 : 1024, w = m / half, mm = m % half;
    return 1024 + (mm >> 7) * 256 + w * 128 + (mm & 127);
}
struct P0Item { const float* src; const float* gsrc; bf16* dst; int N; int f8; };
constexpr int P0_I_EV = 5760, P0_I_OD = 35840, P0_I_PAIR = P0_I_EV + P0_I_OD, P0_NITEMS = 2 * P0_I_PAIR;
__device__ __forceinline__ P0Item p0_decode(Frame& F, int it, int lane) {
    const int lp = it / P0_I_PAIR; int r = it % P0_I_PAIR;
    const float* W; const float* gain = nullptr; bf16* WT; int K = 1024, N, mode = 0, which = 0, f8 = 0;
    if (r < P0_I_EV) {
        if (r < 1024)      { f8 = (MIX8IN_L2 != 0 && lp == 1); W = F.in[3] + (size_t)lp * 1024 * 2048; N = 2048; gain = F.in[1] + (2 * lp) * 1024; WT = ev_w(F, lp, EVO_WIN); mode = 2; }
        else if (r < 1536) { f8 = (MIX8OUT_L2 != 0 && lp == 1); r -= 1024; W = F.in[12] + (size_t)lp * 1024 * 1024; N = 1024; WT = ev_w(F, lp, EVO_WOUT); }
        else if (r < 2944) { f8 = (FFN2_FP8 && lp == 1); r -= 1536; W = F.in[16] + (size_t)lp * 1024 * DFF; N = DFF; gain = F.in[2] + (2 * lp) * 1024; WT = ev_w(F, lp, EVO_W13); mode = 1; which = 0; }
        else if (r < 4352) { f8 = (FFN2_FP8 && lp == 1); r -= 2944; W = F.in[17] + (size_t)lp * 1024 * DFF; N = DFF; gain = F.in[2] + (2 * lp) * 1024; WT = ev_w(F, lp, EVO_W13); mode = 1; which = 1; }
        else               { f8 = (FFN2_FP8 && lp == 1) || (DOWN8_L0 != 0 && lp == 0); r -= 4352; W = F.in[18] + (size_t)lp * DFF * 1024; N = 1024; K = DFF; WT = ev_w(F, lp, EVO_W2); }
    } else {
        r -= P0_I_EV;
        if (r < 1536)      { f8 = (MIX8_L3 != 0 && lp == 1); W = F.in[13] + (size_t)lp * 1024 * 3072; N = 3072; gain = F.in[1] + (2 * lp + 1) * 1024; WT = od_w(F, lp, ODO_WIN); mode = 3; }
        else if (r < 2048) { f8 = (MIX8_L3 != 0 && lp == 1); r -= 1536; W = F.in[15] + (size_t)lp * 1024 * 1024; N = 1024; WT = od_w(F, lp, ODO_WOUT); }
        else { r -= 2048; const int e = r / 4224, q = r % 4224, t = q / 1408; r = q % 1408; const size_t le = (size_t)(lp * NE + e); f8 = MOE_FP8;
            if (t == 0)      { W = F.in[20] + le * 1024 * DFF; N = DFF; gain = F.in[2] + (2 * lp + 1) * 1024; WT = (bf16*)((unsigned char*)od_w(F, lp, ODO_W13) + (size_t)e * NFF2 * 1024 * (MOE_FP8 ? 1 : 2)); mode = 1; which = 0; }
            else if (t == 1) { W = F.in[21] + le * 1024 * DFF; N = DFF; gain = F.in[2] + (2 * lp + 1) * 1024; WT = (bf16*)((unsigned char*)od_w(F, lp, ODO_W13) + (size_t)e * NFF2 * 1024 * (MOE_FP8 ? 1 : 2)); mode = 1; which = 1; }
            else             { W = F.in[22] + le * DFF * 1024; N = 1024; K = DFF; WT = (bf16*)((unsigned char*)od_w(F, lp, ODO_W2) + (size_t)e * 1024 * DFF * (MOE_FP8 ? 1 : 2)); } }
    }
    const int nblk = N / 32, kb = r / nblk, nb = r % nblk, k0 = 64 * kb, n0 = 32 * nb;
    P0Item p; p.N = N; p.f8 = f8;
    p.src = W + (size_t)(k0 + (lane >> 3)) * N + n0 + 4 * (lane & 7);
    p.gsrc = gain ? gain + k0 + (lane >> 3) : nullptr;
    { const size_t eoff = (size_t)(p0_drow(mode, which, n0) + (lane >> 1)) * K + k0 + 32 * (lane & 1); p.dst = f8 ? (bf16*)((unsigned char*)WT + eoff) : WT + eoff; }
    return p;
}
__device__ __forceinline__ void p0_load(const P0Item& p, f32x4 (&v)[8], float (&g)[8]) {
#pragma unroll
    for (int i = 0; i < 8; ++i) { v[i] = __builtin_nontemporal_load((const GAS f32x4*)(p.src + (size_t)(8 * i) * p.N)); g[i] = p.gsrc ? p.gsrc[8 * i] : 1.0f; }
}
__device__ __forceinline__ void p0_store(const P0Item& p, const f32x4 (&v)[8], const float (&g)[8], LAS float* T, int lane) {
    const int r = lane >> 3, c4 = lane & 7;
#pragma unroll
    for (int i = 0; i < 8; ++i)
#pragma unroll
        for (int j = 0; j < 4; ++j) T[(4 * c4 + j) * 68 + 8 * i + r] = v[i][j] * g[i];
    LDS_WAIT(); asm volatile("" ::: "memory");
    const LAS f32x4* row = (const LAS f32x4*)(T + (lane >> 1) * 68 + 32 * (lane & 1));
    if (p.f8) {
#pragma unroll
        for (int q = 0; q < 2; ++q) { const pg8::u32x2 lo = pg8::pack8_fp8(row[4 * q] * pg8::W8_SCALE, row[4 * q + 1] * pg8::W8_SCALE), hi = pg8::pack8_fp8(row[4 * q + 2] * pg8::W8_SCALE, row[4 * q + 3] * pg8::W8_SCALE);
            v4u o; o.x = lo.x; o.y = lo.y; o.z = hi.x; o.w = hi.y; *(GAS v4u*)((unsigned char*)p.dst + 16 * q) = o; }
    } else {
#pragma unroll
    for (int q = 0; q < 4; ++q) { const f32x4 a = row[2 * q], b = row[2 * q + 1];
        v4u o; o.x = cvt_pk_bf16(a[0], a[1]); o.y = cvt_pk_bf16(a[2], a[3]); o.z = cvt_pk_bf16(b[0], b[1]); o.w = cvt_pk_bf16(b[2], b[3]);
        *(GAS v4u*)(p.dst + 8 * q) = o; }
    }
    LDS_WAIT(); asm volatile("" ::: "memory");
}
__device__ __forceinline__ void p0_convert_range(Frame& F, int first, int last, int start, int stride) {
    LAS float* T = (LAS float*)(F.lds + F.wave * 16384);
    int it = first + start; P0Item cur; f32x4 va[8]; float ga[8];
    if (it < last) { cur = p0_decode(F, it, F.lane); p0_load(cur, va, ga); }
#pragma unroll 1
    while (it < last) {
        const int nit = it + stride; P0Item nxt = cur; f32x4 vb[8]; float gb[8];
        if (nit < last) { nxt = p0_decode(F, nit, F.lane); p0_load(nxt, vb, gb); }
        p0_store(cur, va, ga, T, F.lane);
        if (nit < last) {
#pragma unroll
            for (int i = 0; i < 8; ++i) { va[i] = vb[i]; ga[i] = gb[i]; } }
        cur = nxt; it = nit;
    }
}
constexpr int FILL_CHUNK = 16, FILL_NCHUNK = P0_I_PAIR / FILL_CHUNK;
#ifndef BAR_FILL
#define BAR_FILL 0
#endif
constexpr int BF_SLOTS = 14, BF_WAVES = NWAVES - 1;
__device__ __forceinline__ int bf_nstat(int G) { const int n = (BF_SLOTS * G * BF_WAVES) & ~(FILL_CHUNK - 1); return (BAR_FILL && FILL_TAILS) ? (n < P0_I_PAIR ? n : P0_I_PAIR) : 0; }
static_assert(P0_I_PAIR % FILL_CHUNK == 0, "filler chunks");
__device__ __forceinline__ void fill_convert(Frame& F, int nmax) {
#if FILL_TAILS
#pragma unroll 1
    for (int c = 0; c < nmax; ++c) {
        if (F.tid == 0) F.MISC[16] = __hip_atomic_fetch_add((unsigned*)((gu32*)(F.ws + WS_CTL) + CW_FILL), 1u, __ATOMIC_RELAXED, __HIP_MEMORY_SCOPE_AGENT);
        __syncthreads();
        const unsigned ch = F.MISC[16];
        __syncthreads();
        const int nstat = bf_nstat(F.G);
        if (ch >= (unsigned)((P0_I_PAIR - nstat) / FILL_CHUNK)) break;
        p0_convert_range(F, P0_I_PAIR + nstat + (int)ch * FILL_CHUNK, P0_I_PAIR + nstat + (int)ch * FILL_CHUNK + FILL_CHUNK, F.wave, NWAVES);
    }
#endif
}
__device__ __forceinline__ void half_unit_wait(int ticks) { const unsigned long long t0 = __builtin_amdgcn_s_memrealtime(); while (__builtin_amdgcn_s_memrealtime() - t0 < (unsigned long long)ticks) __builtin_amdgcn_s_sleep(32); }
__device__ __forceinline__ void stagger_wait(int c, int unit_ticks) {
#if STAGGER
    const unsigned long long t0 = __builtin_amdgcn_s_memrealtime(); const unsigned long long d = (unsigned long long)(((unsigned)c * 37u) & 15u) * (unsigned)unit_ticks / 16u;
    while (__builtin_amdgcn_s_memrealtime() - t0 < d) __builtin_amdgcn_s_sleep(32);
#endif
}
__device__ __forceinline__ bool fill_idle(int nwg, int G, int c) { const int mine = (nwg > c) ? (nwg - c + G - 1) / G : 0; return mine < (nwg + G - 1) / G; }
#if !MK_PER_PHASE
__device__ __forceinline__ void xcd_barrier_fill(const XcdBarrier& b, Frame& F, int slot) {
    asm volatile("s_waitcnt vmcnt(0)" ::: "memory");
    __syncthreads();
    const int wave = opaque_s(F.wave);
    if (wave == 0) {
      if (threadIdx.x == 0) {
        unsigned* bar = b.bar;
        __builtin_amdgcn_s_waitcnt(0);
        unsigned nloc = b.st[0], nx = b.st[1];
        if (nloc == 0u) { unsigned ev_ = 0u; xcd_barrier_complete(bar, b.x, nloc, nx, ev_); b.st[0] = nloc; b.st[1] = nx; }
        const unsigned old = xb_add(&bar[XB_XSUB(b.x)], 1u);
        const unsigned gen = old / nloc;
        if (old + 1u == (gen + 1u) * nloc) {
            __builtin_amdgcn_fence(__ATOMIC_RELEASE, "agent");
            asm volatile("s_waitcnt vmcnt(0)" ::: "memory");
            const unsigned og = xb_add(&bar[XB_TOP], 1u);
            const unsigned tg = og / nx;
            if (og + 1u == (tg + 1u) * nx) xb_add(&bar[XB_TOPGEN], 1u);
            else XB_SPIN(xb_ld(&bar[XB_TOPGEN]) == tg, bar);
            __builtin_amdgcn_fence(__ATOMIC_ACQUIRE, "agent");
            xb_add(&bar[XB_XGEN(b.x)], 1u);
            asm volatile("s_waitcnt vmcnt(0)" ::: "memory");
        } else {
            XB_SPIN(xb_ld(&bar[XB_XGEN(b.x)]) == gen, bar);
            __builtin_amdgcn_fence(__ATOMIC_ACQUIRE, "agent");
            asm volatile("s_waitcnt vmcnt(0)" ::: "memory");
        }
      }
    } else {
        const int idx = (slot * F.G + F.vcu) * BF_WAVES + wave - 1;
        if (idx < bf_nstat(F.G)) {
            const int lane = opaque_v(F.tid) & 63;
            LAS float* T = (LAS float*)(F.lds + wave * 16384);
            const P0Item it = p0_decode(F, P0_I_PAIR + idx, lane); f32x4 v[8]; float g[8];
            p0_load(it, v, g); p0_store(it, v, g, T, lane);
        }
    }
    __syncthreads();
}
#endif
__device__ __forceinline__ void p0_prologue(Frame& F) {
    const int gw = F.vcu * NWAVES + F.wave, NGW = F.G * NWAVES;
    p0_convert_range(F, 0, FILL_TAILS ? P0_I_PAIR : P0_NITEMS, gw, NGW);
    { bf16* xb = (bf16*)(F.ws + WS_XB); float* ssq0 = ssq_arr(F, 0);
      for (int m = gw; m < M; m += NGW) { const GAS f32x4* xr = (const GAS f32x4*)(F.in[0] + (size_t)m * D) + F.lane; f32x4 v[4]; float s = 0.f;
#pragma unroll
          for (int j = 0; j < 4; ++j) { v[j] = __builtin_nontemporal_load(xr + 64 * j); s += (v[j].x * v[j].x + v[j].y * v[j].y) + (v[j].z * v[j].z + v[j].w * v[j].w); }
          s = wave_sum(s);
          GAS v2u* o8 = (GAS v2u*)(xb + (size_t)m * D) + F.lane;
#pragma unroll
          for (int j = 0; j < 4; ++j) { v2u w; w.x = cvt_pk_bf16(v[j].x, v[j].y); w.y = cvt_pk_bf16(v[j].z, v[j].w); o8[64 * j] = w; }
          ssq_store_row(ssq0, m, F.lane, s); } }
    { float* Rt = (float*)(F.ws + WS_MISC + MI_RT); bf16* WsB = (bf16*)(F.ws + WS_MISC + MI_WSB);
      const int gt = F.vcu * NWAVES * 64 + F.tid, NGT = F.G * NWAVES * 64;
      for (int i = gt; i < 2 * NE * 1024; i += NGT) { const int lp = i / (NE * 1024), e = (i / 1024) % NE, k = i % 1024; Rt[i] = F.in[19][((size_t)lp * 1024 + k) * NE + e] * F.in[2][(2 * lp + 1) * 1024 + k]; }
      for (int i = gt; i < 2 * 4 * 128 * 128 / 2; i += NGT) { const float a = F.in[4][2 * i], b = F.in[4][2 * i + 1]; ((unsigned*)WsB)[i] = cvt_pk_bf16(a, b); } }
}

struct MixBTile { v4u v[12]; };
__device__ __forceinline__ void mix_b_request(Frame& F, int hc, int tid, MixBTile& T) {
    const bf16* glu = (const bf16*)(F.ws + WS_R3 + WS_GLU_OFF); const int R0 = hc * 64, p0 = R0 % SEQ;
#pragma unroll
    for (int i = 0; i < 12; ++i) { const int idx = tid + i * NWAVES * 64, r = idx >> 6, c16 = idx & 63, pos = p0 - 15 + r;
        T.v[i] = (v4u){0u, 0u, 0u, 0u}; if (idx < 94 * 64 && pos >= 0 && pos < SEQ) T.v[i] = *(const GAS v4u*)(glu + (size_t)(R0 - 15 + r) * BW + 8 * c16); }
}
constexpr int VN_STRIDE = 520;
__device__ __forceinline__ void mix_unit_a(Frame& F, int lp, int chunk, int hp, int hc, MixBTile& BT, int& tid_out) {
    const bf16* za = (const bf16*)(F.ws + WS_R1); bf16* mix = (bf16*)(F.ws + WS_R2); const f32x2* lna = (const f32x2*)(F.ws + WS_MISC + MI_LNA);
    const int R0 = chunk * CHUNK, w = F.wave, l = opaque_v(F.lane), tid = 64 * w + l; tid_out = tid;
    LAS f32x2* stat = (LAS f32x2*)(F.lds + 128 * VN_STRIDE);
    v4u raw[8];
    { const bf16* src = za + (size_t)(R0 + 16 * w + (l >> 5)) * 1024 + 512 + 256 * hp + 8 * (l & 31);
#pragma unroll
      for (int i = 0; i < 8; ++i) raw[i] = *(const GAS v4u*)(src + (size_t)(2 * i) * 1024); }
    const int h = 2 * hp + (w >> 2), tq = w & 3, li = l & 15, g = l >> 4;
    LAS unsigned char* AU = F.lds + 128 * VN_STRIDE + 1024;
    { v4u aur[8];
#pragma unroll
      for (int i = 0; i < 8; ++i) { const int idx = tid + 512 * i, row = idx >> 5, c = idx & 31; aur[i] = *(const GAS v4u*)(za + (size_t)(R0 + row) * 1024 + 256 * hp + 8 * c); }
#pragma unroll
      for (int i = 0; i < 8; ++i) { const int idx = tid + 512 * i, row = idx >> 5, c = idx & 31; *(LAS v4u*)(AU + row * 528 + 16 * c) = aur[i]; } }
    const bf16* WsB = (const bf16*)(F.ws + WS_MISC + MI_WSB) + (size_t)(lp * 4 + h) * 128 * 128;
    bf16x8 Y[2][4];
#pragma unroll
    for (int mt = 0; mt < 2; ++mt)
#pragma unroll
        for (int kk = 0; kk < 4; ++kk) Y[mt][kk] = *(const GAS bf16x8*)(WsB + (size_t)(32 * tq + 16 * mt + li) * 128 + 32 * kk + 8 * g);
    if (tid < 128) { float s = 0.f, q = 0.f;
#pragma unroll
        for (int p = 0; p < 8; ++p) { const f32x2 v = lna[(size_t)p * M + R0 + tid]; s += v.x; q += v.y; }
        const float mean = s * (1.0f / AW), var = fmaxf(q * (1.0f / AW) - mean * mean, 0.f); stat[tid] = (f32x2){mean, __builtin_amdgcn_rsqf(var + LN_EPS)}; }
    const int c0 = 256 * hp + 8 * (l & 31);
    const f32x4 g0 = *(const GAS f32x4*)(F.in[6] + lp * AW + c0), g1 = *(const GAS f32x4*)(F.in[6] + lp * AW + c0 + 4);
    const f32x4 b0 = *(const GAS f32x4*)(F.in[7] + lp * AW + c0), b1 = *(const GAS f32x4*)(F.in[7] + lp * AW + c0 + 4);
    __syncthreads();
#pragma unroll
    for (int i = 0; i < 8; ++i) { const int row = 16 * w + (l >> 5) + 2 * i; const f32x2 st = stat[row];
        f32x4 v0, v1; v0[0] = bf_lo(raw[i].x); v0[1] = bf_hi(raw[i].x); v0[2] = bf_lo(raw[i].y); v0[3] = bf_hi(raw[i].y); v1[0] = bf_lo(raw[i].z); v1[1] = bf_hi(raw[i].z); v1[2] = bf_lo(raw[i].w); v1[3] = bf_hi(raw[i].w);
        v0 = (v0 - st.x) * st.y * g0 + b0; v1 = (v1 - st.x) * st.y * g1 + b1;
        LAS v2u* dst = (LAS v2u*)(F.lds + row * VN_STRIDE + 16 * (l & 31));
        v2u p0, p1; p0.x = cvt_pk_bf16(v0[0], v0[1]); p0.y = cvt_pk_bf16(v0[2], v0[3]); p1.x = cvt_pk_bf16(v1[0], v1[1]); p1.y = cvt_pk_bf16(v1[2], v1[3]);
        dst[0] = p0; dst[1] = p1; }
    __syncthreads();
    mix_b_request(F, hc, tid, BT);
    {
        const float* bs = F.in[5] + (lp * 4 + h) * 128;
#pragma unroll
        for (int nt = 0; nt < 8; ++nt) {
            f32x4 acc[2];
#pragma unroll
            for (int mt = 0; mt < 2; ++mt) acc[mt] = (f32x4){0.f, 0.f, 0.f, 0.f};
#pragma unroll
            for (int kk = 0; kk < 4; ++kk) {
                const LAS unsigned short* xp = (const LAS unsigned short*)(F.lds + (32 * kk + 8 * g) * VN_STRIDE + 2 * (128 * (w >> 2) + 16 * nt + li));
                bf16x8 X;
#pragma unroll
                for (int j = 0; j < 8; ++j) X[j] = (short)xp[j * (VN_STRIDE / 2)];
#pragma unroll
                for (int mt = 0; mt < 2; ++mt) acc[mt] = __builtin_amdgcn_mfma_f32_16x16x32_bf16(X, Y[mt][kk], acc[mt], 0, 0, 0);
            }
#pragma unroll
            for (int mt = 0; mt < 2; ++mt) { const int t = 32 * tq + 16 * mt + li, d0 = 16 * nt + 4 * g; const float bias = bs[t];
                const size_t off = (size_t)(R0 + t) * 1024 + 128 * h + d0;
                LAS v2u* aup = (LAS v2u*)(AU + t * 528 + 2 * (128 * (w >> 2) + d0)); const v2u au = *aup;
                v2u o; o.x = cvt_pk_bf16(bf_lo(au.x) * (acc[mt][0] + bias), bf_hi(au.x) * (acc[mt][1] + bias)); o.y = cvt_pk_bf16(bf_lo(au.y) * (acc[mt][2] + bias), bf_hi(au.y) * (acc[mt][3] + bias));
                *aup = o; }
        }
    }
    __syncthreads();
#pragma unroll
    for (int i = 0; i < 8; ++i) { const int idx = tid + 512 * i, row = idx >> 5, c = idx & 31; const v4u av = *(const LAS v4u*)(AU + row * 528 + 16 * c);
        if ((MIX8OUT_L2 != 0) && lp == 1) { int lo = 0, hi = 0; lo = __builtin_amdgcn_cvt_pk_fp8_f32(bf_lo(av.x), bf_hi(av.x), lo, false); lo = __builtin_amdgcn_cvt_pk_fp8_f32(bf_lo(av.y), bf_hi(av.y), lo, true);
            hi = __builtin_amdgcn_cvt_pk_fp8_f32(bf_lo(av.z), bf_hi(av.z), hi, false); hi = __builtin_amdgcn_cvt_pk_fp8_f32(bf_lo(av.w), bf_hi(av.w), hi, true);
            v2u o8; o8.x = (unsigned)lo; o8.y = (unsigned)hi; *(GAS v2u*)((GAS unsigned char*)mix + (size_t)(R0 + row) * 1024 + 256 * hp + 8 * c) = o8; }
        else *(GAS v4u*)(mix + (size_t)(R0 + row) * 1024 + 256 * hp + 8 * c) = av; }
    __syncthreads();
}
__device__ __forceinline__ void mix_unit_b(Frame& F, int lp, int hc, int tid, const MixBTile& T) {
    bf16* mix = (bf16*)(F.ws + WS_R2);
    const int R0 = hc * 64, lane = tid & 63;
#pragma unroll
    for (int i = 0; i < 12; ++i) { const int idx = tid + i * NWAVES * 64, r = idx >> 6, c16 = idx & 63; if (idx < 94 * 64) *(LAS v4u*)(F.lds + r * 1024 + 16 * c16) = T.v[i]; }
    const int cp = tid & 255, grp = tid >> 8, wg4 = F.wave & 3;
    f32x2 wt[KB];
#pragma unroll
    for (int j = 0; j < KB; ++j) wt[j] = *(const GAS f32x2*)(F.in[8] + ((size_t)lp * KB + j) * BW + 2 * cp);
    const f32x2 cb = *(const GAS f32x2*)(F.in[9] + lp * BW + 2 * cp), lg = *(const GAS f32x2*)(F.in[10] + lp * BW + 2 * cp), lb = *(const GAS f32x2*)(F.in[11] + lp * BW + 2 * cp);
    LAS float* red = (LAS float*)(F.lds + 98304);
    LAS float* st = (LAS float*)(F.lds + 98304 + 1024);
    __syncthreads();
#pragma unroll 1
    for (int run = 0; run < 2; ++run) {
        const int o0 = 32 * grp + 16 * run;
        f32x2 acc[16];
#pragma unroll
        for (int o = 0; o < 16; ++o) acc[o] = cb;
        unsigned xc[4], xn[4];
#pragma unroll
        for (int i = 0; i < 4; ++i) xc[i] = *(const LAS unsigned*)(F.lds + (o0 + i) * 1024 + 4 * cp);
#pragma unroll
        for (int rb = 0; rb < 48; rb += 4) {
#pragma unroll
            for (int i = 0; i < 4; ++i) { xn[i] = 0u; if (rb + 4 + i < 46) xn[i] = *(const LAS unsigned*)(F.lds + (o0 + rb + 4 + i) * 1024 + 4 * cp); }
#pragma unroll
            for (int i = 0; i < 4; ++i) { const int r = rb + i; if (r < 46) { const f32x2 x = (f32x2){bf_lo(xc[i]), bf_hi(xc[i])};
#pragma unroll
                for (int o = 0; o < 16; ++o) { if (r - o >= 0 && r - o < KB) acc[o] = __builtin_elementwise_fma(wt[r - o], x, acc[o]); } } }
            __builtin_amdgcn_sched_barrier(0);
#pragma unroll
            for (int i = 0; i < 4; ++i) xc[i] = xn[i]; }
        { float v[32];
#pragma unroll
          for (int o = 0; o < 16; ++o) { v[o] = acc[o].x + acc[o].y; v[16 + o] = acc[o].x * acc[o].x + acc[o].y * acc[o].y; }
          reduce_scatter_step<32, 32, 32>(v, lane); reduce_scatter_step<16, 32, 16>(v, lane); reduce_scatter_step<8, 32, 8>(v, lane); reduce_scatter_step<4, 32, 4>(v, lane); reduce_scatter_step<2, 32, 2>(v, lane);
          const float tot = v[0] + pg8::xor_get<1>(v[0], lane);
          if ((lane & 1) == 0) red[(grp * 4 + wg4) * 32 + (lane >> 1)] = tot; }
        __syncthreads();
        if (tid < 32) { const int gg = tid >> 4, o = tid & 15; float s = 0.f, q = 0.f;
#pragma unroll
            for (int k = 0; k < 4; ++k) { s += red[(gg * 4 + k) * 32 + o]; q += red[(gg * 4 + k) * 32 + 16 + o]; }
            const float mean = s * (1.0f / BW), var = fmaxf(q * (1.0f / BW) - mean * mean, 0.f);
            st[(gg * 16 + o) * 2] = mean; st[(gg * 16 + o) * 2 + 1] = __builtin_amdgcn_rsqf(var + LN_EPS); }
        __syncthreads();
#pragma unroll
        for (int o = 0; o < 16; ++o) { const float mean = st[(grp * 16 + o) * 2], rstd = st[(grp * 16 + o) * 2 + 1];
            const float y0 = (acc[o].x - mean) * rstd * lg.x + lb.x, y1 = (acc[o].y - mean) * rstd * lg.y + lb.y;
            if ((MIX8OUT_L2 != 0) && lp == 1) { const int w8 = __builtin_amdgcn_cvt_pk_fp8_f32(siluf_fast(y0), siluf_fast(y1), 0, false); *(GAS unsigned short*)((GAS unsigned char*)mix + (size_t)(R0 + o0 + o) * 1024 + 512 + 2 * cp) = (unsigned short)w8; }
            else *(GAS unsigned*)(mix + (size_t)(R0 + o0 + o) * 1024 + 512 + 2 * cp) = cvt_pk_bf16(siluf_fast(y0), siluf_fast(y1)); }
    }
    __syncthreads();
}

__device__ __forceinline__ void conv3_phase(Frame& F, int lp) {
    const bf16* gb = (const bf16*)(F.ws + WS_R1); const bf16* cv = (const bf16*)(F.ws + WS_R1 + 32 * MiB); bf16* y = (bf16*)(F.ws + WS_R2);
    const int gw = F.vcu * NWAVES + F.wave, NGW = F.G * NWAVES; const bool y8 = (MIX8_L3 != 0) && lp == 1;
    for (int item = gw; item < 2 * (M / 16); item += NGW) {
        const int r0 = (item >> 1) * 16, ch0 = 512 * (item & 1) + 8 * F.lane, p = r0 % SEQ;
        f32x4 w[3][2];
#pragma unroll
        for (int j = 0; j < 3; ++j) { w[j][0] = *(const GAS f32x4*)(F.in[14] + ((size_t)lp * 3 + j) * 1024 + ch0); w[j][1] = *(const GAS f32x4*)(F.in[14] + ((size_t)lp * 3 + j) * 1024 + ch0 + 4); }
        v4u prev = (v4u){0u, 0u, 0u, 0u}; if (p > 0) prev = *(const GAS v4u*)(cv + (size_t)(r0 - 1) * 1024 + ch0);
        v4u cur = *(const GAS v4u*)(cv + (size_t)r0 * 1024 + ch0);
#pragma unroll 4
        for (int i = 0; i < 16; ++i) { const int row = r0 + i;
            v4u nxt = (v4u){0u, 0u, 0u, 0u}; if (p + i + 1 < SEQ) nxt = *(const GAS v4u*)(cv + (size_t)(row + 1) * 1024 + ch0);
            const v4u g = *(const GAS v4u*)(gb + (size_t)row * 1024 + ch0);
            v4u o; float f[8];
#pragma unroll
            for (int k = 0; k < 4; ++k) { const int a = (2 * k) & 3, b = (2 * k + 1) & 3, hh = k >> 1;
                const float c0 = w[0][hh][a] * bf_lo(prev[k]) + w[1][hh][a] * bf_lo(cur[k]) + w[2][hh][a] * bf_lo(nxt[k]);
                const float c1 = w[0][hh][b] * bf_hi(prev[k]) + w[1][hh][b] * bf_hi(cur[k]) + w[2][hh][b] * bf_hi(nxt[k]);
                f[2 * k] = bf_lo(g[k]) * c0; f[2 * k + 1] = bf_hi(g[k]) * c1; o[k] = cvt_pk_bf16(f[2 * k], f[2 * k + 1]); }
            if (y8) { int lo = 0, hi = 0; lo = __builtin_amdgcn_cvt_pk_fp8_f32(f[0], f[1], lo, false); lo = __builtin_amdgcn_cvt_pk_fp8_f32(f[2], f[3], lo, true); hi = __builtin_amdgcn_cvt_pk_fp8_f32(f[4], f[5], hi, false); hi = __builtin_amdgcn_cvt_pk_fp8_f32(f[6], f[7], hi, true);
                v2u o8; o8.x = (unsigned)lo; o8.y = (unsigned)hi; *(GAS v2u*)((GAS unsigned char*)y + (size_t)row * 1024 + ch0) = o8; }
            else *(GAS v4u*)(y + (size_t)row * 1024 + ch0) = o;
            prev = cur; cur = nxt; }
    }
}

__device__ __forceinline__ void router_phase(Frame& F, int lp, const float* ssq) {
    const bf16* xb = (const bf16*)(F.ws + WS_XB); const float* Rt = (const float*)(F.ws + WS_MISC + MI_RT) + (size_t)lp * NE * 1024;
    int* tok_e = (int*)(F.ws + WS_MISC + MI_TOKE); float* tok_g = (float*)(F.ws + WS_MISC + MI_TOKG); int* tok_r = (int*)(F.ws + WS_MISC + MI_TOKR); int* cnt = (int*)(F.ws + WS_MISC + MI_CNT); float* tok_rs = (float*)(F.ws + WS_MISC + MI_TOKRS);
    LAS int* te = (LAS int*)(F.lds);
    LAS float* lgs = (LAS float*)(F.lds + 1024) + F.wave * 64;
    const int l = F.lane;
    for (int vb = opaque_s(F.vcu); vb < M / 64; vb += F.G) {
        const int t0 = 64 * vb + 8 * F.wave;
        float sA = (l < 32) ? ssq[(size_t)(l & 3) * M + t0 + (l >> 2)] : 0.f;
        float v[64];
        v4u xall[8], xcll[8];
#pragma unroll
        for (int j = 0; j < 8; ++j) { xall[j] = *(const GAS v4u*)(xb + (size_t)(t0 + j) * 1024 + 8 * l); xcll[j] = *(const GAS v4u*)(xb + (size_t)(t0 + j) * 1024 + 512 + 8 * l); }
#pragma unroll
        for (int hb = 0; hb < 2; ++hb) {
            v4u xa[4], xc[4];
#pragma unroll
            for (int j = 0; j < 4; ++j) { xa[j] = xall[4 * hb + j]; xc[j] = xcll[4 * hb + j]; }
#pragma unroll
            for (int e = 0; e < NE; ++e) { const f32x4 r0 = *(const GAS f32x4*)(Rt + e * 1024 + 8 * l), r1 = *(const GAS f32x4*)(Rt + e * 1024 + 8 * l + 4), r2 = *(const GAS f32x4*)(Rt + e * 1024 + 512 + 8 * l), r3 = *(const GAS f32x4*)(Rt + e * 1024 + 512 + 8 * l + 4);
#pragma unroll
                for (int j = 0; j < 4; ++j) { const v4u a = xa[j], b = xc[j];
                    f32x4 s = (f32x4){bf_lo(a.x), bf_hi(a.x), bf_lo(a.y), bf_hi(a.y)} * r0; s = s + (f32x4){bf_lo(a.z), bf_hi(a.z), bf_lo(a.w), bf_hi(a.w)} * r1;
                    s = s + (f32x4){bf_lo(b.x), bf_hi(b.x), bf_lo(b.y), bf_hi(b.y)} * r2; s = s + (f32x4){bf_lo(b.z), bf_hi(b.z), bf_lo(b.w), bf_hi(b.w)} * r3;
                    v[(4 * hb + j) * 8 + e] = (s[0] + s[1]) + (s[2] + s[3]); } }
            __builtin_amdgcn_sched_barrier(0);
        }
        reduce_scatter_step<64, 64, 32>(v, l); reduce_scatter_step<32, 64, 16>(v, l); reduce_scatter_step<16, 64, 8>(v, l); reduce_scatter_step<8, 64, 4>(v, l); reduce_scatter_step<4, 64, 2>(v, l); reduce_scatter_step<2, 64, 1>(v, l);
        lgs[l] = v[0];
        sA += pg8::xor_get<1>(sA, l); sA += pg8::xor_get<2>(sA, l);
        const int jt = l & 7;
        const float rs = __builtin_amdgcn_rsqf(__shfl(sA, 4 * jt) * (1.0f / 1024.0f) + RMS_EPS);
        LDS_WAIT(); asm volatile("" ::: "memory");
        if (l < 8) { float lg[NE];
#pragma unroll
            for (int e = 0; e < NE; ++e) lg[e] = lgs[l * 8 + e];
            int i0 = 0; float v0 = lg[0];
#pragma unroll
            for (int e = 1; e < NE; ++e) if (lg[e] > v0) { v0 = lg[e]; i0 = e; }
            int i1 = -1; float v1 = -3.0e38f;
#pragma unroll
            for (int e = 0; e < NE; ++e) if (e != i0 && lg[e] > v1) { v1 = lg[e]; i1 = e; }
            const float g0 = __builtin_amdgcn_rcpf(1.0f + __expf((v1 - v0) * rs)), g1 = 1.0f - g0;
            const int tl = 8 * F.wave + l, t = t0 + l;
            te[2 * tl] = i0; te[2 * tl + 1] = i1; tok_e[2 * t] = i0; tok_e[2 * t + 1] = i1; tok_g[2 * t] = g0; tok_g[2 * t + 1] = g1; tok_rs[t] = rs; }
        __syncthreads();
        if (F.wave == 0) { const int e0 = te[2 * l], e1 = te[2 * l + 1]; int r0 = 0, r1 = 0, mycnt = 0;
#pragma unroll
            for (int e = 0; e < NE; ++e) { const unsigned long long mk = __ballot(e0 == e || e1 == e); const int rk = __popcll(mk & ((1ull << l) - 1ull)), c = __popcll(mk);
                if (e0 == e) r0 = rk; if (e1 == e) r1 = rk; if (l == e) mycnt = c; }
            const int t = 64 * vb + l; tok_r[2 * t] = r0; tok_r[2 * t + 1] = r1; if (l < NE) cnt[vb * NE + l] = mycnt; }
        __syncthreads();
    }
}
__device__ __forceinline__ void gather_phase(Frame& F) {
    const bf16* xb = (const bf16*)(F.ws + WS_XB); bf16* xg = (bf16*)(F.ws + WS_R1);
    const int* tok_e = (const int*)(F.ws + WS_MISC + MI_TOKE); const float* tok_g = (const float*)(F.ws + WS_MISC + MI_TOKG); const int* tok_r = (const int*)(F.ws + WS_MISC + MI_TOKR);
    int* tok_s = (int*)(F.ws + WS_MISC + MI_TOKS); const int* cnt = (const int*)(F.ws + WS_MISC + MI_CNT); unsigned* hdr = (unsigned*)(F.ws + WS_MISC + MI_HDR);
    const float* tok_rs = (const float*)(F.ws + WS_MISC + MI_TOKRS); float* rsg = (float*)(F.ws + WS_MISC + MI_RSG); float* gtg = (float*)(F.ws + WS_MISC + MI_GTG);
    LAS int* part = (LAS int*)(F.lds);
    LAS int* fin = (LAS int*)(F.lds + 256);
    const int l = F.lane;
    for (int vb = opaque_s((int)blockIdx.x); vb < M / 64; vb += F.G) {
        const int pr_ = 16 * F.wave + (l & 15), tk_ = 64 * vb + (pr_ >> 1), kk_ = pr_ & 1; const int e_pre = tok_e[2 * tk_ + kk_], r_pre = tok_r[2 * tk_ + kk_]; const float rs_pre = tok_rs[tk_], g_pre = tok_g[2 * tk_ + kk_];
#if MOE_FP8
        v4u ra0[8], rb0[8];
#pragma unroll
        for (int j = 0; j < 8; ++j) { const int t = 64 * vb + ((16 * F.wave + j) >> 1); ra0[j] = *(const GAS v4u*)(xb + (size_t)t * 1024 + 16 * l); rb0[j] = *(const GAS v4u*)(xb + (size_t)t * 1024 + 16 * l + 8); }
#endif
        if (F.tid < 256) { int c[16];
            const v4u c0 = *(const GAS v4u*)(cnt + F.tid * NE), c1 = *(const GAS v4u*)(cnt + F.tid * NE + 4);
            c[0] = (int)c0.x; c[1] = (int)c0.y; c[2] = (int)c0.z; c[3] = (int)c0.w; c[4] = (int)c1.x; c[5] = (int)c1.y; c[6] = (int)c1.z; c[7] = (int)c1.w;
#pragma unroll
            for (int e = 0; e < NE; ++e) c[8 + e] = (F.tid < vb) ? c[e] : 0;
#pragma unroll
            for (int st = 0; st < 4; ++st) { const int off = 32 >> st, n = 16 >> st;
#pragma unroll
                for (int i = 0; i < 8; ++i) if (i < n / 2) { const bool hi = (l & off) != 0; const int keep = hi ? c[i + n / 2] : c[i], send = hi ? c[i] : c[i + n / 2]; c[i] = keep + __shfl_xor(send, off); } }
            int tot = c[0]; tot += __shfl_xor(tot, 2); tot += __shfl_xor(tot, 1);
            if ((l & 3) == 0) part[F.wave * 16 + (l >> 2)] = tot; }
        __syncthreads();
        if (F.tid == 0) { int off = 0;
            for (int e = 0; e < NE; ++e) { const int tot = part[e] + part[16 + e] + part[32 + e] + part[48 + e], bas = part[8 + e] + part[24 + e] + part[40 + e] + part[56 + e];
                const int pc = (tot + 255) & ~255; fin[e] = off + bas; fin[8 + e] = pc; off += pc; } }
        __syncthreads();
        if (vb == 0 && F.tid == 0) { unsigned p = 0; for (int e = 0; e < NE; ++e) { const int np_e = fin[8 + e] >> 8; for (int i = 0; i < np_e; ++i) hdr[1 + p++] = (unsigned)e; } hdr[0] = p; }
        int slot = 0;
        { slot = fin[e_pre] + r_pre;
          if (l < 16) { rsg[slot] = rs_pre; gtg[slot] = g_pre; tok_s[2 * tk_ + kk_] = slot; } }
#pragma unroll
        for (int bt = 0; bt < 2; ++bt) {
#if MOE_FP8
            v4u ra[8], rb[8];
#pragma unroll
            for (int j = 0; j < 8; ++j) { if (bt == 0) { ra[j] = ra0[j]; rb[j] = rb0[j]; } else { const int t = 64 * vb + ((16 * F.wave + 8 * bt + j) >> 1); ra[j] = *(const GAS v4u*)(xb + (size_t)t * 1024 + 16 * l); rb[j] = *(const GAS v4u*)(xb + (size_t)t * 1024 + 16 * l + 8); } }
#pragma unroll
            for (int j = 0; j < 8; ++j) { const int sl = __builtin_amdgcn_readlane(slot, 8 * bt + j); const v4u a = ra[j], b = rb[j];
                const pg8::u32x2 lo = pg8::pack8_fp8((f32x4){bf_lo(a.x), bf_hi(a.x), bf_lo(a.y), bf_hi(a.y)}, (f32x4){bf_lo(a.z), bf_hi(a.z), bf_lo(a.w), bf_hi(a.w)});
                const pg8::u32x2 hi = pg8::pack8_fp8((f32x4){bf_lo(b.x), bf_hi(b.x), bf_lo(b.y), bf_hi(b.y)}, (f32x4){bf_lo(b.z), bf_hi(b.z), bf_lo(b.w), bf_hi(b.w)});
                v4u o; o.x = lo.x; o.y = lo.y; o.z = hi.x; o.w = hi.y; *(GAS v4u*)((unsigned char*)xg + (size_t)sl * 1024 + 16 * l) = o; }
#else
            v4u ra[8], rb[8];
#pragma unroll
            for (int j = 0; j < 8; ++j) { const int t = 64 * vb + ((16 * F.wave + 8 * bt + j) >> 1); ra[j] = *(const GAS v4u*)(xb + (size_t)t * 1024 + 8 * l); rb[j] = *(const GAS v4u*)(xb + (size_t)t * 1024 + 512 + 8 * l); }
#pragma unroll
            for (int j = 0; j < 8; ++j) { const int sl = __builtin_amdgcn_readlane(slot, 8 * bt + j); *(GAS v4u*)(xg + (size_t)sl * 1024 + 8 * l) = ra[j]; *(GAS v4u*)(xg + (size_t)sl * 1024 + 512 + 8 * l) = rb[j]; }
#endif
        }
        __syncthreads();
    }
}
__device__ __forceinline__ void combine_phase(Frame& F, float* ssq_next, bool last) {
    float* const OUTP = (float*)F.in[24];
    bf16* xb = (bf16*)(F.ws + WS_XB); const bf16* og = (const bf16*)(F.ws + WS_R2); const int* tok_s = (const int*)(F.ws + WS_MISC + MI_TOKS);
    const int gw = F.vcu * NWAVES + F.wave, NGW = F.G * NWAVES, l = F.lane;
    for (int tb = 2 * gw; tb < M; tb += 2 * NGW) {
        const int sl = (l < 4) ? tok_s[2 * tb + l] : 0;
        int s[4];
#pragma unroll
        for (int i = 0; i < 4; ++i) s[i] = __builtin_amdgcn_readlane(sl, i);
#if MOE_OG8
        v4u xr[2][2]; v2u ar[2][2], br[2][2]; const unsigned char* og8 = (const unsigned char*)og;
#pragma unroll
        for (int q = 0; q < 2; ++q)
#pragma unroll
            for (int hh = 0; hh < 2; ++hh) { const int c0 = 512 * hh + 8 * l; xr[q][hh] = *(const GAS v4u*)(xb + (size_t)(tb + q) * 1024 + c0); ar[q][hh] = *(const GAS v2u*)(og8 + (size_t)s[2 * q] * 1024 + c0); br[q][hh] = *(const GAS v2u*)(og8 + (size_t)s[2 * q + 1] * 1024 + c0); }
#else
        v4u xr[2][2], ar[2][2], br[2][2];
#pragma unroll
        for (int q = 0; q < 2; ++q)
#pragma unroll
            for (int hh = 0; hh < 2; ++hh) { const int c0 = 512 * hh + 8 * l; xr[q][hh] = *(const GAS v4u*)(xb + (size_t)(tb + q) * 1024 + c0); ar[q][hh] = *(const GAS v4u*)(og + (size_t)s[2 * q] * 1024 + c0); br[q][hh] = *(const GAS v4u*)(og + (size_t)s[2 * q + 1] * 1024 + c0); }
#endif
#pragma unroll
        for (int q = 0; q < 2; ++q) { const int t = tb + q;
            float xn[16]; float ss = 0.f;
#pragma unroll
#if MOE_OG8
            for (int hh = 0; hh < 2; ++hh) { const v4u x = xr[q][hh]; const v2u a = ar[q][hh], b = br[q][hh];
#pragma unroll
                for (int d = 0; d < 2; ++d) {
                    const f32x2 a0 = __builtin_amdgcn_cvt_pk_f32_fp8((int)a[d], false), a1 = __builtin_amdgcn_cvt_pk_f32_fp8((int)a[d], true), b0 = __builtin_amdgcn_cvt_pk_f32_fp8((int)b[d], false), b1 = __builtin_amdgcn_cvt_pk_f32_fp8((int)b[d], true);
                    xn[8 * hh + 4 * d + 0] = bf_lo(x[2 * d]) + (a0.x + b0.x) * pg8::OG8_INV; xn[8 * hh + 4 * d + 1] = bf_hi(x[2 * d]) + (a0.y + b0.y) * pg8::OG8_INV;
                    xn[8 * hh + 4 * d + 2] = bf_lo(x[2 * d + 1]) + (a1.x + b1.x) * pg8::OG8_INV; xn[8 * hh + 4 * d + 3] = bf_hi(x[2 * d + 1]) + (a1.y + b1.y) * pg8::OG8_INV; } }
#else
            for (int hh = 0; hh < 2; ++hh) { const v4u x = xr[q][hh], a = ar[q][hh], b = br[q][hh];
#pragma unroll
                for (int k = 0; k < 4; ++k) { xn[8 * hh + 2 * k] = bf_lo(x[k]) + bf_lo(a[k]) + bf_lo(b[k]); xn[8 * hh + 2 * k + 1] = bf_hi(x[k]) + bf_hi(a[k]) + bf_hi(b[k]); } }
#endif
#pragma unroll
            for (int i = 0; i < 16; ++i) ss += xn[i] * xn[i];
            ss = wave_sum(ss);
            if (!last) {
#pragma unroll
                for (int hh = 0; hh < 2; ++hh) { v4u o;
#pragma unroll
                    for (int k = 0; k < 4; ++k) o[k] = cvt_pk_bf16(xn[8 * hh + 2 * k], xn[8 * hh + 2 * k + 1]);
                    *(GAS v4u*)(xb + (size_t)t * 1024 + 512 * hh + 8 * l) = o;
                    if (MIX8IN_L2 != 0) { int lo = 0, hi = 0; lo = __builtin_amdgcn_cvt_pk_fp8_f32(xn[8 * hh], xn[8 * hh + 1], lo, false); lo = __builtin_amdgcn_cvt_pk_fp8_f32(xn[8 * hh + 2], xn[8 * hh + 3], lo, true);
                        hi = __builtin_amdgcn_cvt_pk_fp8_f32(xn[8 * hh + 4], xn[8 * hh + 5], hi, false); hi = __builtin_amdgcn_cvt_pk_fp8_f32(xn[8 * hh + 6], xn[8 * hh + 7], hi, true);
                        v2u o8; o8.x = (unsigned)lo; o8.y = (unsigned)hi; *(GAS v2u*)(F.ws + WS_R3 + (size_t)t * 1024 + 512 * hh + 8 * l) = o8; } }
                ssq_store_row(ssq_next, t, l, ss);
            } else { const float r = __builtin_amdgcn_rsqf(ss * (1.0f / 1024.0f) + RMS_EPS);
#pragma unroll
                for (int hh = 0; hh < 2; ++hh) { const int c0 = 512 * hh + 8 * l; const f32x4 g0 = *(const GAS f32x4*)(F.in[23] + c0), g1 = *(const GAS f32x4*)(F.in[23] + c0 + 4);
                    f32x4 o0, o1;
#pragma unroll
                    for (int k = 0; k < 4; ++k) { o0[k] = xn[8 * hh + k] * r * g0[k]; o1[k] = xn[8 * hh + 4 + k] * r * g1[k]; }
                    *(GAS f32x4*)(OUTP + (size_t)t * 1024 + c0) = o0; *(GAS f32x4*)(OUTP + (size_t)t * 1024 + c0 + 4) = o1; }
            }
        }
    }
}
__device__ __forceinline__ void finalize_phase(Frame& F) {
    float* const OUTP = (float*)F.in[24];
    const bf16* xb = (const bf16*)(F.ws + WS_XB);
    const int gw = F.vcu * NWAVES + F.wave, NGW = F.G * NWAVES, l = F.lane;
    for (int t = gw; t < M; t += NGW) {
        float xn[16]; float ss = 0.f;
#pragma unroll
        for (int hh = 0; hh < 2; ++hh) { const v4u x = *(const GAS v4u*)(xb + (size_t)t * 1024 + 512 * hh + 8 * l);
#pragma unroll
            for (int k = 0; k < 4; ++k) { xn[8 * hh + 2 * k] = bf_lo(x[k]); xn[8 * hh + 2 * k + 1] = bf_hi(x[k]); } }
#pragma unroll
        for (int i = 0; i < 16; ++i) ss += xn[i] * xn[i];
        ss = wave_sum(ss); const float r = __builtin_amdgcn_rsqf(ss * (1.0f / 1024.0f) + RMS_EPS);
#pragma unroll
        for (int hh = 0; hh < 2; ++hh) { const int c0 = 512 * hh + 8 * l; const f32x4 g0 = *(const GAS f32x4*)(F.in[23] + c0), g1 = *(const GAS f32x4*)(F.in[23] + c0 + 4);
            f32x4 o0, o1;
#pragma unroll
            for (int k = 0; k < 4; ++k) { o0[k] = xn[8 * hh + k] * r * g0[k]; o1[k] = xn[8 * hh + 4 + k] * r * g1[k]; }
            *(GAS f32x4*)(OUTP + (size_t)t * 1024 + c0) = o0; *(GAS f32x4*)(OUTP + (size_t)t * 1024 + c0 + 4) = o1; }
    }
}

#if MK_PER_PHASE
struct BarT { int unused; };
#define GRID_BAR() do { } while (0)
#else
typedef XcdBarrier BarT;
#define GRID_BAR() xcd_barrier(bar_)
#endif
#ifndef PH_ENABLE
#define PH_ENABLE 0x3fff
#endif
#define PH_ON(j) (((PH_ENABLE) >> (j)) & 1)
#ifndef DUP_MASK
#define DUP_MASK 0
#endif
#define NREP(j) ((((DUP_MASK) >> (j)) & 1) ? 2 : 1)
#define IN(k) (lo <= (k) && (k) < hi && (k) <= MK_LAST_PHASE)
#ifdef BAR_TWICE
#define SEAM(k) do { if (IN(k) && (k) + 1 < hi) { GRID_BAR(); GRID_BAR(); } } while (0)
#else
#if BAR_FILL && FILL_TAILS && !MK_PER_PHASE
#define SEAM(k) do { if (IN(k) && (k) + 1 < hi) { if ((k) < BF_SLOTS) xcd_barrier_fill(bar_, F, (k)); else GRID_BAR(); } } while (0)
#else
#if !MK_PER_PHASE
#define SEAM_LOCAL(k) ((k) >= 1 && ((((k) - 1) % 13) == 1 || (((k) - 1) % 13) == 2 || (((k) - 1) % 13) == 3 || (((k) - 1) % 13) == 4 || (((k) - 1) % 13) == 6 || (((k) - 1) % 13) == 7))
#define SEAM(k) do { if (IN(k) && (k) + 1 < hi) { if (LOCAL_BAR != 0 && SEAM_LOCAL(k) && bar_.st[2] != 0u) xcd_local_barrier(bar_); else GRID_BAR(); } } while (0)
#else
#define SEAM(k) do { if (IN(k) && (k) + 1 < hi) GRID_BAR(); } while (0)
#endif
#endif
#endif
#define xb ((bf16*)(wsl + WS_XB))
#define r1 ((bf16*)(wsl + WS_R1))
#define r1b ((bf16*)(wsl + WS_R1 + 32 * MiB))
#define r2 ((bf16*)(wsl + WS_R2))
#define r3 ((bf16*)(wsl + WS_R3))
#define x8a ((bf16*)(wsl + WS_R3 + 128 * MiB))
#define gluB ((bf16*)(wsl + WS_R3 + WS_GLU_OFF))
#define x8b ((bf16*)(wsl + WS_R3 + 144 * MiB))
#define SQ(s) ((float*)(wsl + WS_SSQ) + (size_t)(s) * 4 * M)
#define LOCALF() Frame Fl = F; Fl.tid = opaque_v(F.tid); Fl.lane = Fl.tid & 63; Fl.wave = opaque_s(F.wave); Fl.vcu = opaque_s(F.vcu); Fl.in = opaque_tab(F.in); Fl.ws = wsl; const int bx = opaque_s(bx0); (void)bx
#define PH_BEGIN(j, id) if (PH_ON(j) && IN(id)) { _Pragma("unroll 1") for (int rep_ = 0; rep_ < NREP(j); ++rep_) { if (rep_) GRID_BAR(); GAS unsigned char* wsl = F.ws; asm volatile("" : "+s"(wsl));
#define PH_END(id) } } SEAM(id);
template <int lp> __device__ __forceinline__ void pair_body(Frame& F, const BarT& bar_, const int lo, const int hi, const int bx0) {
        const int pb = 1 + 13 * lp;
        PH_BEGIN(0, pb + 0) const int bx = opaque_s(bx0); constexpr bool I8 = (MIX8IN_L2 != 0 && lp == 1); pg8::Gemm g{I8 ? r3 : xb, ev_wl(wsl, lp, EVO_WIN), M, EV_IN, D}; pg8::StaticOrder S; S.init(M, EV_IN, F.G, bx, WGM_E1);
            pg8::EpiEvenInT<I8> E{r1, gluB, SQ(4 * lp), (pg8::f32x2*)(wsl + WS_MISC + MI_LNA)}; pg8::gemm_phase<pg8::EpiEvenInT<I8>, pg8::StaticOrder, EPI_ALIGN_HEAVY, true, I8>(F.lds, g, S, E); PH_END(pb + 0)
        PH_BEGIN(1, pb + 1) LOCALF(); for (int u = Fl.vcu; u < 256; u += F.G) {     MixBTile BT; int tid_; _Pragma("unroll 1") for (int ra = 0; ra < NREP(14); ++ra) mix_unit_a(Fl, lp, u >> 1, u & 1, u, BT, tid_); _Pragma("unroll 1") for (int rb = 0; rb < NREP(15); ++rb) mix_unit_b(Fl, lp, u, tid_, BT); } PH_END(pb + 1)
        PH_BEGIN(2, pb + 2) const int bx = opaque_s(bx0); pg8::Gemm g{r2, ev_wl(wsl, lp, EVO_WOUT), M, D, D}; pg8::StaticOrder S; S.init(M, D, F.G, bx, WGM_N4);
            constexpr bool X8 = (FFN2_FP8 && lp == 1), O8 = (MIX8OUT_L2 != 0 && lp == 1); pg8::EpiRes<X8, O8> E{xb, SQ(4 * lp + 1), (unsigned char*)x8a, (LAS float*)(F.lds + RED_OFF)}; pg8::gemm_phase<pg8::EpiRes<X8, O8>, pg8::StaticOrder, true, true, O8>(F.lds, g, S, E); PH_END(pb + 2)
        PH_BEGIN(3, pb + 3) const int bx = opaque_s(bx0); constexpr bool F8 = (FFN2_FP8 && lp == 1); pg8::Gemm g{F8 ? x8a : xb, ev_wl(wsl, lp, EVO_W13), M, NFF2, D}; pg8::StaticOrder S; S.init(M, NFF2, F.G, bx, WGM_E4);
            constexpr bool O8 = F8 || (DOWN8_L0 != 0 && lp == 0); typedef pg8::EpiGlu<false, O8, F8 && (GLU_WT != 0)> EpiE4; EpiE4 E{r3, DFF, SQ(4 * lp + 1), F8 ? pg8::W8_INV : 1.0f, F.lds + STG_OFF}; if (fill_idle(S.nwg, F.G, bx)) stagger_wait(bx, F8 ? 1600 : 2800); pg8::gemm_phase<EpiE4, pg8::StaticOrder, EPI_ALIGN_HEAVY, true, F8>(F.lds, g, S, E);
            if constexpr (lp == 0) { if (fill_idle(S.nwg, F.G, bx)) { LOCALF(); fill_convert(Fl, FILL_N_E4); } } PH_END(pb + 3)
        PH_BEGIN(4, pb + 4) const int bx = opaque_s(bx0); pg8::Gemm g{r3, ev_wl(wsl, lp, EVO_W2), M, D, DFF}; pg8::StaticOrder S; S.init(M, D, F.G, bx, WGM_N4);
            constexpr bool F8 = (FFN2_FP8 && lp == 1) || (DOWN8_L0 != 0 && lp == 0); constexpr bool XO = (MIX8_L3 != 0 && lp == 1); pg8::EpiRes<XO, F8> E{xb, SQ(4 * lp + 2), (unsigned char*)x8b, (LAS float*)(F.lds + RED_OFF)}; pg8::gemm_phase<pg8::EpiRes<XO, F8>, pg8::StaticOrder, true, true, F8>(F.lds, g, S, E); PH_END(pb + 4)
        PH_BEGIN(5, pb + 5) const int bx = opaque_s(bx0); constexpr bool M8 = (MIX8_L3 != 0 && lp == 1); pg8::Gemm g{M8 ? x8b : xb, od_wl(wsl, lp, ODO_WIN), M, OD_IN, D}; pg8::StaticOrder S; S.init(M, OD_IN, F.G, bx, WGM_O1);
            pg8::EpiOddInT<M8> E{r1, r1b, SQ(4 * lp + 2)}; pg8::gemm_phase<pg8::EpiOddInT<M8>, pg8::StaticOrder, EPI_ALIGN_HEAVY, true, M8>(F.lds, g, S, E); PH_END(pb + 5)
        PH_BEGIN(6, pb + 6) LOCALF(); conv3_phase(Fl, lp); PH_END(pb + 6)
        PH_BEGIN(7, pb + 7) const int bx = opaque_s(bx0); pg8::Gemm g{r2, od_wl(wsl, lp, ODO_WOUT), M, D, D}; pg8::StaticOrder S; S.init(M, D, F.G, bx, WGM_N4);
            constexpr bool M8 = (MIX8_L3 != 0 && lp == 1); pg8::EpiRes<false, M8> E{xb, SQ(4 * lp + 3), nullptr, (LAS float*)(F.lds + RED_OFF)}; pg8::gemm_phase<pg8::EpiRes<false, M8>, pg8::StaticOrder, true, true, M8>(F.lds, g, S, E); PH_END(pb + 7)
        PH_BEGIN(8, pb + 8) LOCALF(); router_phase(Fl, lp, SQ(4 * lp + 3)); PH_END(pb + 8)
        PH_BEGIN(9, pb + 9) LOCALF(); gather_phase(Fl); PH_END(pb + 9)
        PH_BEGIN(10, pb + 10) const int bx = opaque_s(bx0); const unsigned* hdr = (const unsigned*)(wsl + WS_MISC + MI_HDR);
            int np = __builtin_amdgcn_readfirstlane((int)__hip_atomic_load(hdr, RLX_AGENT)); np = np > MAXP ? MAXP : np;
            { LAS unsigned* ptab = (LAS unsigned*)(F.lds + PTAB_OFF); const int tid_ = opaque_v(F.tid); if (tid_ < MAXP) ptab[tid_] = (tid_ < np) ? __hip_atomic_load(hdr + 1 + tid_, RLX_AGENT) : 0u; __syncthreads(); }
            constexpr bool CH = MOE_CHAIN != 0; typedef pg8::MoeOrderT<CH, false> OrdT; typedef pg8::EpiGlu<true, MOE_FP8 != 0, CH || (GLU_WT != 0 && MOE_FP8 != 0)> EpiT;
            pg8::Gemm g{r1, od_wl(wsl, lp, ODO_W13), np * 256, NFF2, D};
            OrdT S; S.init(np * 256, NFF2, F.G, bx, WGM_O6); S.tab = (const LAS unsigned*)(F.lds + PTAB_OFF); S.estride = (size_t)NFF2 * D * (MOE_FP8 ? 1 : 2);
            S.cnt = (unsigned*)((gu32*)(wsl + WS_CTL) + CW_PCNT + lp * PCNT_WORDS); S.need = 0u; S.tmo = (unsigned*)((gu32*)(wsl + WS_CTL) + CW_TMO);
            EpiT E{r3, DFF, (const float*)(wsl + WS_MISC + MI_RSG), MOE_FP8 ? pg8::W8_INV : 1.0f, F.lds + STG_OFF}; if (fill_idle(S.nwg, F.G, bx)) stagger_wait(bx, MOE_FP8 ? 1700 : 3000);
#if XCD_STAGGER
            if (bx & 1) half_unit_wait(XCD_STAGGER);
#endif
#ifdef PROBE_FAKE
            if (NREP(10) == 2 && rep_ == 0) pg8::gemm_phase<EpiT, OrdT, EPI_ALIGN_HEAVY, F8_SP2, MOE_FP8 != 0, true>(F.lds, g, S, E); else
#endif
            pg8::gemm_phase<EpiT, OrdT, EPI_ALIGN_HEAVY, F8_SP2, MOE_FP8 != 0>(F.lds, g, S, E);
            if constexpr (lp == 0 && !CH) { if (fill_idle(S.nwg, F.G, bx)) { LOCALF(); fill_convert(Fl, 3); } }
#if MOE_CHAIN
        } }
#else
        PH_END(pb + 10)
#endif
        PH_BEGIN(11, pb + 11) const int bx = opaque_s(bx0); const unsigned* hdr = (const unsigned*)(wsl + WS_MISC + MI_HDR);
            int np = __builtin_amdgcn_readfirstlane((int)__hip_atomic_load(hdr, RLX_AGENT)); np = np > MAXP ? MAXP : np;
            { LAS unsigned* ptab = (LAS unsigned*)(F.lds + PTAB_OFF); const int tid_ = opaque_v(F.tid); if (tid_ < MAXP) ptab[tid_] = (tid_ < np) ? __hip_atomic_load(hdr + 1 + tid_, RLX_AGENT) : 0u; __syncthreads(); }
            constexpr bool CH = MOE_CHAIN != 0; typedef pg8::MoeOrderT<false, CH> OrdT;
            const int cdeal = CH ? (bx - (np * (NFF2 / 256)) % F.G + F.G) % F.G : bx;
            pg8::Gemm g{r3, od_wl(wsl, lp, ODO_W2), np * 256, D, DFF}; OrdT S; S.init(np * 256, D, F.G, cdeal, WGM_O7); S.tab = (const LAS unsigned*)(F.lds + PTAB_OFF); S.estride = (size_t)D * DFF * (MOE_FP8 ? 1 : 2);
            S.cnt = (unsigned*)((gu32*)(wsl + WS_CTL) + CW_PCNT + lp * PCNT_WORDS); S.need = (unsigned)((NFF2 / 256) * NWAVES); S.tmo = (unsigned*)((gu32*)(wsl + WS_CTL) + CW_TMO);
            pg8::EpiMoeDown<MOE_OG8 != 0> E{r2, (const float*)(wsl + WS_MISC + MI_GTG), MOE_FP8 ? pg8::W8_INV : 1.0f}; if (fill_idle(S.nwg, F.G, cdeal)) stagger_wait(cdeal, MOE_FP8 ? 3500 : 7000); pg8::gemm_phase<pg8::EpiMoeDown<MOE_OG8 != 0>, OrdT, true, F8_SP2, MOE_FP8 != 0>(F.lds, g, S, E);
            if constexpr (lp == 0) { if (fill_idle(S.nwg, F.G, cdeal)) { LOCALF(); fill_convert(Fl, FILL_N_O7); } } PH_END(pb + 11)
        PH_BEGIN(12, pb + 12) LOCALF(); combine_phase(Fl, SQ((4 * lp + 4) & 7), lp == 1); if constexpr (lp == 0) fill_convert(Fl, 1 << 30); PH_END(pb + 12)
    }


struct Args { const float* in[24]; float* out; unsigned char* ws; int ph_lo, ph_hi; };
__global__ void __launch_bounds__(NWAVES * 64, 2) enc_fwd(Args args) {
    extern __shared__ __attribute__((aligned(16))) unsigned char lds[];
    Frame F;
    F.lds = (LAS unsigned char*)lds;
    F.MISC = (volatile LAS unsigned*)(F.lds + MISC_OFF);
    F.tid = threadIdx.x; F.lane = F.tid & 63; F.wave = __builtin_amdgcn_readfirstlane(F.tid >> 6);
    F.G = gridDim.x; { const int bx = blockIdx.x; F.vcu = (F.G % 8 == 0) ? (bx % 8) * (F.G / 8) + bx / 8 : bx; }
    F.ws = (GAS unsigned char*)args.ws;
    F.in = (intab_t)__builtin_amdgcn_kernarg_segment_ptr();
    for (int u = F.tid; u < 128; u += NWAVES * 64) ((LAS unsigned*)(F.lds + MISC_OFF))[u] = 0u;
    __syncthreads();
#if MK_PER_PHASE
    const BarT bar_{0};
#else
    const BarT bar_ = xcd_barrier_post((unsigned*)((gu32*)(F.ws + WS_CTL) + CW_BAR), F.MISC + 8);
#endif
    const int lo = args.ph_lo, hi = args.ph_hi;
    const int bx0 = (int)blockIdx.x;
    PH_BEGIN(13, 0) LOCALF(); p0_prologue(Fl); PH_END(0)

    pair_body<0>(F, bar_, lo, hi, bx0);
    pair_body<1>(F, bar_, lo, hi, bx0);
#if MK_LAST_PHASE < 26
    if (hi == NPHASE + 1) { if (lo < NPHASE) GRID_BAR(); LOCALF(); finalize_phase(Fl); }
#endif
#undef IN
#undef xb
#undef r1
#undef r1b
#undef r2
#undef r3
#undef x8a
#undef gluB
#undef x8b
#undef SQ
#undef SEAM
}

extern "C" void kernel_launch(void* const* d_in, const int* in_sizes, int n_in, void* d_out, int out_size, void* d_ws, size_t ws_size, hipStream_t stream) {
    static int grid = 0;
    if (grid == 0) {
        if (n_in != 24 || in_sizes[0] != M * D || out_size != M * D || ws_size < WS_END) { fprintf(stderr, "kernel_launch: unexpected shapes (n_in %d, in0 %d, out %d, ws %zu < %zu); nothing launched\n", n_in, n_in > 0 ? in_sizes[0] : -1, out_size, ws_size, (size_t)WS_END); grid = -1; return; }
        int dev = 0, cus = 0, per_cu = 0;
        if (hipGetDevice(&dev) != hipSuccess || hipDeviceGetAttribute(&cus, hipDeviceAttributeMultiprocessorCount, dev) != hipSuccess) { grid = -1; return; }
        if (hipFuncSetAttribute((const void*)enc_fwd, hipFuncAttributeMaxDynamicSharedMemorySize, LDS_BYTES) != hipSuccess) { fprintf(stderr, "kernel_launch: hipFuncSetAttribute failed\n"); grid = -1; return; }
        if (hipOccupancyMaxActiveBlocksPerMultiprocessor(&per_cu, (const void*)enc_fwd, NWAVES * 64, LDS_BYTES) != hipSuccess || per_cu < 1) fprintf(stderr, "kernel_launch: note: occupancy query reports %d workgroups per CU\n", per_cu);
        (void)hipGetLastError();
        grid = cus;
    }
    if (grid < 0) return;
    if (hipMemsetAsync((char*)d_ws + WS_CTL, 0, CTL_ZERO_BYTES, stream) != hipSuccess) { fprintf(stderr, "kernel_launch: hipMemsetAsync failed\n"); return; }
    Args a{};
    for (int i = 0; i < 24; ++i) a.in[i] = (const float*)d_in[i];
    a.out = (float*)d_out; a.ws = (unsigned char*)d_ws;
    constexpr int NPH_RUN = (MK_LAST_PHASE < 26) ? NPHASE + 1 : NPHASE;
#if MK_PER_PHASE
    for (int p = 0; p < NPH_RUN; ++p) { if (p < NPHASE && p > MK_LAST_PHASE) continue; a.ph_lo = p; a.ph_hi = p + 1;
        hipLaunchKernelGGL(enc_fwd, dim3(grid), dim3(NWAVES * 64), LDS_BYTES, stream, a); }
#else
    a.ph_lo = 0; a.ph_hi = NPH_RUN;
    hipLaunchKernelGGL(enc_fwd, dim3(grid), dim3(NWAVES * 64), LDS_BYTES, stream, a);
#endif
    const hipError_t le = hipPeekAtLastError();
    if (le != hipSuccess) fprintf(stderr, "kernel_launch: launch failed: %s\n", hipGetErrorName(le));
}
```
